# Optimizing an MI355X kernel written in HIP

```python
import math
import jax, jax.numpy as jnp
from jax import lax
import numpy as np

D_MODEL = 2048
BATCH = 4
SEQ = 8192
DEPTH = 2

MEM_LEN = 256
HEAD_DIM = 64
A_WIDTH = 3 * D_MODEL // 8
A_HEADS = A_WIDTH // HEAD_DIM
A_PATTERNS = ((128, 1), (512, 4), (2048, 16))
B_WIDTH = D_MODEL // 4
B_HEADS = B_WIDTH // HEAD_DIM
BLOCK_Q = 128
C_HEADS = 4
C_VW = 3 * D_MODEL // 8
C_DV = C_VW // C_HEADS
C_DK = C_DV // 2
C_KW = C_HEADS * C_DK
C_GATE_RANK = 16
C_GATE_TAU = 16.0
C_CHUNK = 64
MIX_WIDTH = A_WIDTH + B_WIDTH + C_VW
PROJ_SPLITS = (A_WIDTH, A_WIDTH, A_WIDTH, B_WIDTH, B_WIDTH, B_WIDTH, B_HEADS, C_KW, C_KW, C_VW, C_VW, C_GATE_RANK)
PROJ_WIDTH = sum(PROJ_SPLITS)
CROSS_HEADS = 4
CROSS_DH = 128
CROSS_WIDTH = CROSS_HEADS * CROSS_DH
D_FF = ((8 * D_MODEL // 3 + 127) // 128) * 128
CONV_W = 3
REL_BUCKETS = 32
REL_MAX_DIST = 2048
EPS = 1e-6

kernel_name = 'hybrid_dilated_fox_gla_block'


def rms_norm(x, g):
    xf = x.astype(jnp.float32)
    y = xf * lax.rsqrt(jnp.mean(xf * xf, axis=-1, keepdims=True) + EPS)
    return (y * g.astype(jnp.float32)).astype(x.dtype)


def t5_bucket(dist):
    max_exact = REL_BUCKETS // 2
    d = np.maximum(dist, 1).astype(np.float32)
    large = max_exact + (np.log(d / max_exact) / math.log(REL_MAX_DIST / max_exact)
                         * (REL_BUCKETS - max_exact)).astype(np.int32)
    return np.where(dist < max_exact, dist, np.minimum(large, REL_BUCKETS - 1)).astype(np.int32)


def dilated_pattern(q, k, v, rel_table, window, dilation):
    B, S, H, Dh = q.shape
    span = window // dilation
    L = S // dilation
    nb = -(-L // span)
    Lp = nb * span

    def classes(t):
        t = t.reshape(B, L, dilation, H, Dh).transpose(0, 3, 2, 1, 4)
        return jnp.pad(t, ((0, 0), (0, 0), (0, 0), (0, Lp - L), (0, 0)))

    def band(t):
        t = jnp.pad(classes(t), ((0, 0), (0, 0), (0, 0), (span, 0), (0, 0)))
        t = t.reshape(B, H, dilation, nb + 1, span, Dh)
        return jnp.concatenate([t[:, :, :, :-1], t[:, :, :, 1:]], axis=4)

    qb = classes(q).reshape(B, H, dilation, nb, span, Dh)
    kb, vb = band(k), band(v)
    i = np.arange(span)[:, None]
    j = np.arange(2 * span)[None, :]
    step = i + span - j
    valid = (step >= 0) & (step <= span) & (np.arange(nb)[:, None, None] * span + j - span >= 0)
    bias = rel_table[t5_bucket(np.clip(step, 0, span) * dilation)]
    bias = jnp.transpose(bias, (2, 0, 1)).astype(jnp.float32)
    logits = jnp.einsum('bhrnid,bhrnjd->bhrnij', qb, kb,
                        preferred_element_type=jnp.float32) * HEAD_DIM ** -0.5
    logits = jnp.where(valid, logits + bias[None, :, None, None], -jnp.inf)
    m = jnp.max(logits, axis=-1, keepdims=True)
    p = jnp.exp(logits - m)
    s = jnp.sum(p, axis=-1, keepdims=True)
    o = jnp.einsum('bhrnij,bhrnjd->bhrnid', p.astype(v.dtype), vb,
                   preferred_element_type=jnp.float32) / s
    lse = (m + jnp.log(s))[..., 0]
    o = o.reshape(B, H, dilation, Lp, Dh)[:, :, :, :L].transpose(0, 3, 2, 1, 4).reshape(B, S, H, Dh)
    lse = lse.reshape(B, H, dilation, Lp)[:, :, :, :L].transpose(0, 3, 2, 1).reshape(B, S, H)
    return o, lse


def dilated_mixture_attention(q, k, v, rel_table):
    outs, lses = [], []
    for window, dilation in A_PATTERNS:
        o, lse = dilated_pattern(q, k, v, rel_table, window, dilation)
        outs.append(o)
        lses.append(lse)
    w = jax.nn.softmax(jnp.stack(lses, axis=0), axis=0)
    return jnp.sum(w[..., None] * jnp.stack(outs, axis=0), axis=0)


def forgetting_attention(q, k, v, f_logit):
    B, S, H, Dh = q.shape
    c = jnp.cumsum(jax.nn.log_sigmoid(f_logit.astype(jnp.float32)), axis=1)
    cT = c.transpose(0, 2, 1)
    nq = S // BLOCK_Q
    qb = q.reshape(B, nq, BLOCK_Q, H, Dh).transpose(1, 0, 2, 3, 4)
    cb = cT.reshape(B, H, nq, BLOCK_Q).transpose(2, 0, 1, 3)
    kpos = jnp.arange(S)

    def block(args):
        n, qn, cn = args
        logits = jnp.einsum('bihd,bjhd->bhij', qn, k,
                            preferred_element_type=jnp.float32) * HEAD_DIM ** -0.5
        logits = logits + (cn[..., :, None] - cT[..., None, :])
        qpos = n * BLOCK_Q + jnp.arange(BLOCK_Q)
        logits = jnp.where(kpos[None, :] <= qpos[:, None], logits, -jnp.inf)
        p = jax.nn.softmax(logits, axis=-1)
        return jnp.einsum('bhij,bjhd->bihd', p.astype(v.dtype), v)

    ob = lax.map(block, (jnp.arange(nq), qb, cb))
    return ob.transpose(1, 0, 2, 3, 4).reshape(B, S, H, Dh)


def gla_chunked(q, k, v, log_alpha):
    B, S, H, DK = q.shape
    nc = S // C_CHUNK

    def chunks(t):
        return t.astype(jnp.float32).reshape(B, nc, C_CHUNK, H, t.shape[-1]).transpose(1, 0, 3, 2, 4)

    qc, kc, vc, gc = chunks(q * DK ** -0.5), chunks(k), chunks(v), chunks(log_alpha)
    causal = np.tril(np.ones((C_CHUNK, C_CHUNK), dtype=bool))[:, :, None]

    def step(state, inp):
        qn, kn, vn, gn = inp
        b = jnp.cumsum(gn, axis=2)
        o_inter = jnp.einsum('bhik,bhkv->bhiv', qn * jnp.exp(b), state)
        diff = b[:, :, :, None, :] - b[:, :, None, :, :]
        decay = jnp.exp(jnp.where(causal, diff, -jnp.inf))
        a = jnp.einsum('bhik,bhjk,bhijk->bhij', qn, kn, decay)
        o_intra = jnp.einsum('bhij,bhjv->bhiv', a, vn)
        b_last = b[:, :, -1:, :]
        state = state * jnp.exp(b_last[:, :, 0, :])[..., None] + \
            jnp.einsum('bhjk,bhjv->bhkv', kn * jnp.exp(b_last - b), vn)
        return state, o_inter + o_intra

    state0 = jnp.zeros((B, H, DK, v.shape[-1]), jnp.float32)
    _, o = lax.scan(step, state0, (qc, kc, vc, gc))
    return o.transpose(1, 0, 3, 2, 4).reshape(B, S, H, v.shape[-1])


def hybrid_mixer(h, w_in, f_bias, rel_table, c_gate_w2, c_gate_b, c_norm, w_out):
    B, S, _ = h.shape
    proj = h @ w_in
    qa, ka, va, qb, kb, vb, fl, qc, kc, vc, rc, gl = jnp.split(
        proj, np.cumsum(PROJ_SPLITS)[:-1].tolist(), axis=-1)

    def heads(t, n):
        return t.reshape(B, S, n, -1)

    o_a = dilated_mixture_attention(heads(qa, A_HEADS), heads(ka, A_HEADS), heads(va, A_HEADS), rel_table)
    o_b = forgetting_attention(heads(qb, B_HEADS), heads(kb, B_HEADS), heads(vb, B_HEADS), fl + f_bias)
    log_alpha = jax.nn.log_sigmoid((gl @ c_gate_w2 + c_gate_b).astype(jnp.float32)) / C_GATE_TAU
    o_c = gla_chunked(heads(qc, C_HEADS), heads(kc, C_HEADS), heads(vc, C_HEADS), heads(log_alpha, C_HEADS))
    o_c = rms_norm(o_c.astype(h.dtype), c_norm).reshape(B, S, C_VW) * jax.nn.silu(rc)
    mixed = jnp.concatenate([o_a.reshape(B, S, A_WIDTH).astype(h.dtype),
                             o_b.reshape(B, S, B_WIDTH).astype(h.dtype),
                             o_c.astype(h.dtype)], axis=-1)
    return mixed @ w_out


def memory_cross_attention(h, mem_n, w_q, w_kv, w_o):
    B, S, _ = h.shape
    M = mem_n.shape[1]
    q = (h @ w_q).reshape(B, S, CROSS_HEADS, CROSS_DH)
    k, v = jnp.split(mem_n @ w_kv, 2, axis=-1)
    k = k.reshape(B, M, CROSS_HEADS, CROSS_DH)
    v = v.reshape(B, M, CROSS_HEADS, CROSS_DH)
    logits = jnp.einsum('bshd,bmhd->bhsm', q, k, preferred_element_type=jnp.float32) * CROSS_DH ** -0.5
    p = jax.nn.softmax(logits, axis=-1)
    o = jnp.einsum('bhsm,bmhd->bshd', p.astype(v.dtype), v).reshape(B, S, CROSS_WIDTH)
    return o @ w_o


def conv_ffn(h, w_up, conv_w, conv_b, w_down):
    S = h.shape[1]
    val, gate = jnp.split(h @ w_up, 2, axis=-1)
    gp = jnp.pad(gate, ((0, 0), (CONV_W - 1, 0), (0, 0)))
    g = conv_b
    for i in range(CONV_W):
        g = g + conv_w[i] * gp[:, i:i + S]
    return (jax.nn.silu(g) * val) @ w_down


def setup_inputs(seed: int = 0) -> dict:
    key = jax.random.key(seed)
    ks = jax.random.split(key, 21)

    def nrm(k, shape, scale):
        return jax.random.normal(k, shape, jnp.float32) * scale

    def gain(k, shape):
        return 1.0 + 0.05 * jax.random.normal(k, shape, jnp.float32)

    return {
        'x': nrm(ks[0], (BATCH, SEQ, D_MODEL), 1.0),
        'mem': nrm(ks[1], (BATCH, MEM_LEN, D_MODEL), 1.0),
        'rel_table': nrm(ks[2], (REL_BUCKETS, A_HEADS), 0.5),
        'mem_norm': gain(ks[3], (D_MODEL,)),
        'norm_final': gain(ks[4], (D_MODEL,)),
        'norm_mix': gain(ks[5], (DEPTH, D_MODEL)),
        'w_in': nrm(ks[6], (DEPTH, D_MODEL, PROJ_WIDTH), D_MODEL ** -0.5),
        'f_bias': 3.0 + nrm(ks[7], (DEPTH, B_HEADS), 0.1),
        'c_gate_w2': nrm(ks[8], (DEPTH, C_GATE_RANK, C_KW), C_GATE_RANK ** -0.5),
        'c_gate_b': nrm(ks[9], (DEPTH, C_KW), 0.1),
        'c_norm': gain(ks[10], (DEPTH, C_DV)),
        'w_out': nrm(ks[11], (DEPTH, MIX_WIDTH, D_MODEL), MIX_WIDTH ** -0.5),
        'norm_cross': gain(ks[12], (DEPTH, D_MODEL)),
        'w_cq': nrm(ks[13], (DEPTH, D_MODEL, CROSS_WIDTH), D_MODEL ** -0.5),
        'w_ckv': nrm(ks[14], (DEPTH, D_MODEL, 2 * CROSS_WIDTH), D_MODEL ** -0.5),
        'w_co': nrm(ks[15], (DEPTH, CROSS_WIDTH, D_MODEL), CROSS_WIDTH ** -0.5),
        'norm_ffn': gain(ks[16], (DEPTH, D_MODEL)),
        'w_up': nrm(ks[17], (DEPTH, D_MODEL, 2 * D_FF), D_MODEL ** -0.5),
        'conv_w': nrm(ks[18], (DEPTH, CONV_W, D_FF), CONV_W ** -0.5),
        'conv_b': nrm(ks[19], (DEPTH, D_FF), 0.02),
        'w_down': nrm(ks[20], (DEPTH, D_FF, D_MODEL), D_FF ** -0.5),
    }


def reference(x, mem, rel_table, mem_norm, norm_final, norm_mix, w_in, f_bias, c_gate_w2,
              c_gate_b, c_norm, w_out, norm_cross, w_cq, w_ckv, w_co, norm_ffn, w_up,
              conv_w, conv_b, w_down):
    mem_n = rms_norm(mem, mem_norm)
    for l in range(DEPTH):
        x = x + hybrid_mixer(rms_norm(x, norm_mix[l]), w_in[l], f_bias[l], rel_table,
                             c_gate_w2[l], c_gate_b[l], c_norm[l], w_out[l])
        x = x + memory_cross_attention(rms_norm(x, norm_cross[l]), mem_n, w_cq[l], w_ckv[l], w_co[l])
        x = x + conv_ffn(rms_norm(x, norm_ffn[l]), w_up[l], conv_w[l], conv_b[l], w_down[l])
    return rms_norm(x, norm_final)
```

```cpp
#include <hip/hip_runtime.h>
#include <hip/hip_cooperative_groups.h>
#include <cstdio>
#include <cstdint>
#include <cmath>
namespace cg = cooperative_groups;
__device__ __forceinline__ int otid() { int t = threadIdx.x; asm volatile("" : "+v"(t)); return t; }
namespace pg8 {
#define PG8_LAS __attribute__((address_space(3)))
typedef unsigned short bf16_t;
typedef short bf16x8 __attribute__((ext_vector_type(8)));
typedef float f32x4 __attribute__((ext_vector_type(4)));
typedef unsigned u32x4 __attribute__((ext_vector_type(4)));
constexpr int BM = 256, BK = 64, HALF = 128, HTB = HALF * BK * 2  , STAGE_BYTES = 8 * HTB, NXCD = 8, WGM = 4;

__host__ __device__ __forceinline__ int lds_byte(int r, int c) { const int st = (r >> 4) * 2 + (c >> 5), rr = r & 15, cc = c & 31, ob = rr * 64 + cc * 2; return st * 1024 + (ob ^ (((ob >> 9) & 1) << 5)); }
__host__ __device__ __forceinline__ void stage_rc(int b, int& R, int& C) { const int st = b / 1024, sb = b % 1024, swz = sb ^ (((sb >> 9) & 1) << 5); R = (st >> 1) * 16 + swz / 64; C = (st & 1) * 32 + (swz % 64) / 2; }
__host__ __device__ __forceinline__ int perm32(int rho) { const int n = rho >> 4, i = rho & 15; return 8 * (i >> 2) + 4 * n + (i & 3); }

struct Unit { int pm, pn; };
struct Gemm { const bf16_t* A; const bf16_t* Bt; int M, N, K; };

struct StaticOrder {
    int nM, nN, nwg, G, c;
    __host__ __device__ void init(int M, int N, int G_, int c_) { nM = M / BM; nN = N / BM; nwg = nM * nN; G = G_; c = c_; }
    __host__ __device__ bool next(int i, Unit& u) const {
        const long L = (long)i * G + c; if (L >= nwg) return false;
        int wgid = (int)L; { const int q = nwg / NXCD, r = nwg % NXCD, xcd = wgid % NXCD, off = wgid / NXCD; wgid = (xcd < r ? xcd * (q + 1) : r * (q + 1) + (xcd - r) * q) + off; }
        const int nig = WGM * nN, gid = wgid / nig, fm = gid * WGM, gsz = (nM - fm) < WGM ? (nM - fm) : WGM;
        u.pm = fm + ((wgid % nig) % gsz); u.pn = (wgid % nig) / gsz; return true;
    }
    __device__ __forceinline__ void a_ready(const Unit&) const {}
    __device__ __forceinline__ void done(const Unit&) const {}
};

__device__ __forceinline__ unsigned cvt_pk_bf16(float lo, float hi) { unsigned r; asm volatile("v_cvt_pk_bf16_f32 %0, %1, %2" : "=v"(r) : "v"(lo), "v"(hi)); return r; }
typedef float f32x2 __attribute__((ext_vector_type(2)));
struct EpiBf16 {
    static constexpr bool PERM = true, AFTER_DRAIN = false;
    bf16_t* O; int ldc; bf16_t* O2; int ldc2, split;
    const unsigned long long* ss;
    __device__ __forceinline__ void operator()(const f32x4 (&acc)[2][2][4][2], const Unit& u, int wr, int wc, int fr, int fq) const {
        const int row0 = u.pm * BM + wr * 64 + fr; const bool second = split > 0 && u.pn >= split; const int col0 = (second ? u.pn - split : u.pn) * BM + wc * 32 + 8 * fq;
        bf16_t* const Ob = second ? O2 : O; const int ld = second ? ldc2 : ldc;
#pragma unroll
        for (int ai = 0; ai < 2; ++ai)
#pragma unroll
            for (int m = 0; m < 4; ++m) { bf16_t* rowp = Ob + (size_t)(row0 + ai * HALF + m * 16) * ld + col0;
                float rs = 1.f; if (ss) rs = 1.f / sqrtf((float)ss[row0 + ai * HALF + m * 16] * (1.f / (2048.f * 262144.f)) + 1e-6f);
#pragma unroll
                for (int bj = 0; bj < 2; ++bj) { const f32x4 v0 = acc[ai][bj][m][0] * rs, v1 = acc[ai][bj][m][1] * rs;
                    u32x4 w; w.x = cvt_pk_bf16(v0[0], v0[1]); w.y = cvt_pk_bf16(v0[2], v0[3]); w.z = cvt_pk_bf16(v1[0], v1[1]); w.w = cvt_pk_bf16(v1[2], v1[3]);
                    *(u32x4*)(rowp + bj * HALF) = w; } }
    }
};
struct EpiRes {
    static constexpr bool PERM = false, AFTER_DRAIN = false;
    bf16_t* x; int ldc; unsigned long long* ss;
    __device__ __forceinline__ void operator()(const f32x4 (&acc)[2][2][4][2], const Unit& u, int wr, int wc, int fr, int fq) const {
        typedef unsigned u32x2v __attribute__((ext_vector_type(2)));
        const int col0 = u.pn * BM + wc * 32 + 4 * fq;
#pragma unroll
        for (int ai = 0; ai < 2; ++ai)
#pragma unroll
            for (int m = 0; m < 4; ++m) { const int row = u.pm * BM + ai * HALF + wr * 64 + m * 16 + fr; bf16_t* xp = x + (size_t)row * ldc + col0;
                u32x2v bv[2][2];
#pragma unroll
                for (int bj = 0; bj < 2; ++bj)
#pragma unroll
                    for (int n = 0; n < 2; ++n) bv[bj][n] = *(const u32x2v*)(xp + bj * HALF + n * 16);
                float sq = 0.f;
#pragma unroll
                for (int bj = 0; bj < 2; ++bj)
#pragma unroll
                    for (int n = 0; n < 2; ++n) { const f32x4 a = acc[ai][bj][m][n];
                        const float o0 = __builtin_bit_cast(float, bv[bj][n].x << 16) + a[0], o1 = __builtin_bit_cast(float, bv[bj][n].x & 0xffff0000u) + a[1];
                        const float o2 = __builtin_bit_cast(float, bv[bj][n].y << 16) + a[2], o3 = __builtin_bit_cast(float, bv[bj][n].y & 0xffff0000u) + a[3];
                        sq += (o0 * o0 + o1 * o1) + (o2 * o2 + o3 * o3);
                        u32x2v w; w.x = cvt_pk_bf16(o0, o1); w.y = cvt_pk_bf16(o2, o3); *(u32x2v*)(xp + bj * HALF + n * 16) = w; }
                if (ss) { sq += __shfl_xor(sq, 16); sq += __shfl_xor(sq, 32); if (fq == 0) __hip_atomic_fetch_add(ss + row, (unsigned long long)(sq * 262144.f + 0.5f), __ATOMIC_RELAXED, __HIP_MEMORY_SCOPE_AGENT); } }
    }
};
struct EpiConv {
    static constexpr bool PERM = false, AFTER_DRAIN = false;
    bf16_t* ACT; const float* cw; const float* cb; float* GL; float* GF; float* VF; const unsigned long long* ss;
    __device__ __forceinline__ void operator()(const f32x4 (&acc)[2][2][4][2], const Unit& u, int wr, int wc, int fr, int fq) const {
        constexpr int FF = 5504;
        const int lane = otid() & 63;
        const int src1 = (lane & 48) | ((fr + 15) & 15), src2 = (lane & 48) | ((fr + 14) & 15);
        float rs[2][4];
#pragma unroll
        for (int ai = 0; ai < 2; ++ai)
#pragma unroll
            for (int m = 0; m < 4; ++m) rs[ai][m] = 1.f / sqrtf((float)ss[u.pm * BM + ai * HALF + wr * 64 + m * 16 + fr] * (1.f / (2048.f * 262144.f)) + 1e-6f);
#pragma unroll
        for (int n = 0; n < 2; ++n) {
            const int cbase = 128 * u.pn + 32 * wc + 16 * n + 4 * fq;
            const f32x4 w0 = *(const f32x4*)(cw + cbase), w1 = *(const f32x4*)(cw + FF + cbase), w2 = *(const f32x4*)(cw + 2 * FF + cbase), b4 = *(const f32x4*)(cb + cbase);
#pragma unroll
            for (int ai = 0; ai < 2; ++ai) {
                const int slab = u.pm * 4 + 2 * ai + wr;
                f32x4 r1p = (f32x4){0.f, 0.f, 0.f, 0.f}, r2p = (f32x4){0.f, 0.f, 0.f, 0.f};
#pragma unroll
                for (int m = 0; m < 4; ++m) {
                    const f32x4 g = acc[ai][1][m][n] * rs[ai][m], v = acc[ai][0][m][n] * rs[ai][m];
                    f32x4 r1, r2, a;
#pragma unroll
                    for (int e = 0; e < 4; ++e) { r1[e] = __shfl(g[e], src1); r2[e] = __shfl(g[e], src2); }
#pragma unroll
                    for (int e = 0; e < 4; ++e) {
                        const float p1 = fr >= 1 ? r1[e] : r1p[e], p2 = fr >= 2 ? r2[e] : r2p[e];
                        const float gg = b4[e] + w0[e] * p2 + w1[e] * p1 + w2[e] * g[e];
                        a[e] = gg * __builtin_amdgcn_rcpf(1.f + __expf(-gg)) * v[e];
                    }
                    r1p = r1; r2p = r2;
                    const size_t row = (size_t)(u.pm * BM + ai * HALF + wr * 64 + m * 16 + fr);
                    if (m == 0 && fr < 2) {
                        *(f32x4*)(GF + (size_t)(slab * 2 + fr) * FF + cbase) = g; *(f32x4*)(VF + (size_t)(slab * 2 + fr) * FF + cbase) = v;
                    } else {
                        typedef unsigned u32x2v __attribute__((ext_vector_type(2)));
                        u32x2v w; w.x = cvt_pk_bf16(a[0], a[1]); w.y = cvt_pk_bf16(a[2], a[3]);
                        *(u32x2v*)(ACT + row * FF + cbase) = w;
                    }
                    if (m == 3 && fr >= 14) *(f32x4*)(GL + (size_t)(slab * 2 + fr - 14) * FF + cbase) = g;
                }
            }
        }
    }
};
template <class Epi, class Sched, bool ALIGN_EPI = false, bool SP2 = false>
__device__ __forceinline__ void gemm_phase(PG8_LAS unsigned char* lds, const Gemm g, const Sched& S, const Epi& E) {
    const int tid = otid(), wid = __builtin_amdgcn_readfirstlane(tid >> 6), lane = tid & 63, wr = wid >> 2, wc = wid & 3, fr = lane & 15, fq = lane >> 4;
    const int K = g.K, nt = K / BK;
    unsigned voffA[2], voffB[2];
#pragma unroll
    for (int i = 0; i < 2; ++i) { int R, C; stage_rc(tid * 16 + i * 8192, R, C); const int Rb = Epi::PERM ? ((R & ~31) + perm32(R & 31)) : R;
        voffA[i] = (unsigned)(R * K + C) * 2u; voffB[i] = (unsigned)(Rb * K + C) * 2u; }
    const size_t kstep = (size_t)(BK * 2);
    const size_t hstep = (size_t)HALF * K * 2;
    const size_t tstep = 2 * hstep;
    const unsigned ldsw = (unsigned)wid * 1024u;
    const int aoff = lds_byte(wr * 64 + fr, fq * 8), boff = lds_byte(wc * 32 + fr, fq * 8);
#define PG8_SA(b, h) (((b) * 2 + (h)) * HTB)
#define PG8_SB(b, h) ((4 + (b) * 2 + (h)) * HTB)
#define PG8_STAGE(bufoff, gbase, voff) do { _Pragma("unroll") for (int _i = 0; _i < 2; ++_i) \
        __builtin_amdgcn_global_load_lds((const unsigned*)((const char*)(gbase) + (voff)[_i]), (PG8_LAS unsigned*)(lds + (bufoff) + ldsw + _i * 8192), 16, 0, 0); } while (0)
#define PG8_LDA(dst, b, h) do { _Pragma("unroll") for (int m = 0; m < 4; ++m) _Pragma("unroll") for (int k = 0; k < 2; ++k) dst[m][k] = *(const PG8_LAS bf16x8*)(lds + PG8_SA(b, h) + aoff + m * 2048 + k * 1024); } while (0)
#define PG8_LDB(dst, b, h) do { _Pragma("unroll") for (int n = 0; n < 2; ++n) _Pragma("unroll") for (int k = 0; k < 2; ++k) dst[n][k] = *(const PG8_LAS bf16x8*)(lds + PG8_SB(b, h) + boff + n * 2048 + k * 1024); } while (0)
#define PG8_MMA(ai, bj, At, Bt) do { __builtin_amdgcn_s_setprio(1); _Pragma("unroll") for (int m = 0; m < 4; ++m) _Pragma("unroll") for (int n = 0; n < 2; ++n) _Pragma("unroll") for (int k = 0; k < 2; ++k) \
        acc[ai][bj][m][n] = __builtin_amdgcn_mfma_f32_16x16x32_bf16(Bt[n][k], At[m][k], acc[ai][bj][m][n], 0, 0, 0); __builtin_amdgcn_s_setprio(0); } while (0)
#define PG8_WAIT_V(n) asm volatile("s_waitcnt vmcnt(" #n ")" ::: "memory")
#define PG8_WAIT_L(n) asm volatile("s_waitcnt lgkmcnt(" #n ")" ::: "memory")
#define PG8_BAR __builtin_amdgcn_s_barrier()
#define PG8_SCHED __builtin_amdgcn_sched_barrier(0)
    Unit cur, nxt; int ui = 0;
    if (!S.next(0, cur)) return;
    f32x4 acc[2][2][4][2];
#pragma unroll
    for (int a = 0; a < 2; ++a)
#pragma unroll
        for (int b = 0; b < 2; ++b)
#pragma unroll
            for (int m = 0; m < 4; ++m)
#pragma unroll
                for (int n = 0; n < 2; ++n) acc[a][b][m][n] = (f32x4){0.f, 0.f, 0.f, 0.f};
    bf16x8 At[4][2], B0[2][2], B1[2][2];
    const char* cA = (const char*)g.A + (size_t)cur.pm * tstep; const char* cB = (const char*)g.Bt + (size_t)cur.pn * tstep;
    S.a_ready(cur);
    if constexpr (SP2) {
        PG8_STAGE(PG8_SB(0, 0), cB, voffB); PG8_STAGE(PG8_SB(0, 1), cB + hstep, voffB); PG8_STAGE(PG8_SA(0, 0), cA, voffA); PG8_STAGE(PG8_SA(0, 1), cA + hstep, voffA);
        if (wr == 1) PG8_BAR;
        PG8_WAIT_V(2); PG8_BAR;
        PG8_STAGE(PG8_SB(1, 0), cB + kstep, voffB); PG8_STAGE(PG8_SA(1, 0), cA + kstep, voffA); PG8_STAGE(PG8_SB(1, 1), cB + hstep + kstep, voffB);
        PG8_WAIT_V(6); PG8_BAR;
    } else {
        PG8_STAGE(PG8_SB(0, 0), cB, voffB); PG8_STAGE(PG8_SA(0, 0), cA, voffA); PG8_STAGE(PG8_SB(0, 1), cB + hstep, voffB); PG8_STAGE(PG8_SA(0, 1), cA + hstep, voffA);
        if (wr == 1) PG8_BAR;
        PG8_WAIT_V(4); PG8_BAR;
        PG8_STAGE(PG8_SB(1, 0), cB + kstep, voffB); PG8_STAGE(PG8_SA(1, 0), cA + kstep, voffA); PG8_STAGE(PG8_SB(1, 1), cB + hstep + kstep, voffB);
        PG8_WAIT_V(6); PG8_BAR;
    }
    for (;;) {
        const bool has_next = S.next(ui + 1, nxt);
        const char* nA = has_next ? (const char*)g.A + (size_t)nxt.pm * tstep : cA; const char* nB = has_next ? (const char*)g.Bt + (size_t)nxt.pn * tstep : cB;
        for (int t = 0; t < nt; t += 2) {
            const bool last = (t == nt - 2);
            const char* a1 = cA + (size_t)(t + 1) * kstep;
            const char* a2 = last ? nA : cA + (size_t)(t + 2) * kstep; const char* b2 = last ? nB : cB + (size_t)(t + 2) * kstep;
            const char* a3 = a2 + kstep; const char* b3 = b2 + kstep;
            if (last && has_next) S.a_ready(nxt);
            if constexpr (SP2) {
            PG8_LDB(B0, 0, 0); PG8_LDB(B1, 0, 1); PG8_SCHED; PG8_LDA(At, 0, 0); PG8_STAGE(PG8_SA(1, 1), a1 + hstep, voffA);
            PG8_WAIT_V(8); PG8_WAIT_L(0); PG8_BAR; PG8_MMA(0, 0, At, B0); PG8_MMA(0, 1, At, B1); PG8_BAR; PG8_SCHED;
            PG8_LDA(At, 0, 1); PG8_STAGE(PG8_SB(0, 0), b2, voffB); PG8_STAGE(PG8_SB(0, 1), b2 + hstep, voffB); PG8_STAGE(PG8_SA(0, 0), a2, voffA);
            PG8_WAIT_V(8); PG8_WAIT_L(0); PG8_BAR; PG8_MMA(1, 0, At, B0); PG8_MMA(1, 1, At, B1); PG8_BAR; PG8_SCHED;
            PG8_LDB(B0, 1, 0); PG8_LDB(B1, 1, 1); PG8_SCHED; PG8_LDA(At, 1, 0); PG8_STAGE(PG8_SA(0, 1), a2 + hstep, voffA);
            PG8_WAIT_V(8); PG8_WAIT_L(0); PG8_BAR; PG8_MMA(0, 0, At, B0); PG8_MMA(0, 1, At, B1); PG8_BAR; PG8_SCHED;
            PG8_LDA(At, 1, 1); PG8_STAGE(PG8_SB(1, 0), b3, voffB); PG8_STAGE(PG8_SB(1, 1), b3 + hstep, voffB); PG8_STAGE(PG8_SA(1, 0), a3, voffA);
            PG8_WAIT_V(8); PG8_WAIT_L(0); PG8_BAR; PG8_MMA(1, 0, At, B0); PG8_MMA(1, 1, At, B1); PG8_BAR; PG8_SCHED;
            } else {
            PG8_LDB(B0, 0, 0); PG8_SCHED; PG8_LDA(At, 0, 0); PG8_STAGE(PG8_SA(1, 1), a1 + hstep, voffA);
            PG8_WAIT_L(8); PG8_BAR; PG8_WAIT_L(0); PG8_MMA(0, 0, At, B0); PG8_BAR; PG8_SCHED;
            PG8_LDB(B1, 0, 1); PG8_STAGE(PG8_SB(0, 0), b2, voffB);
            PG8_BAR; PG8_WAIT_L(0); PG8_MMA(0, 1, At, B1); PG8_BAR;
            PG8_LDA(At, 0, 1); PG8_STAGE(PG8_SA(0, 0), a2, voffA);
            PG8_BAR; PG8_WAIT_L(0); PG8_MMA(1, 0, At, B0); PG8_BAR; PG8_SCHED;
            PG8_STAGE(PG8_SB(0, 1), b2 + hstep, voffB);
            PG8_WAIT_V(6); PG8_BAR; PG8_MMA(1, 1, At, B1); PG8_BAR;
            PG8_LDB(B0, 1, 0); PG8_SCHED; PG8_LDA(At, 1, 0); PG8_STAGE(PG8_SA(0, 1), a2 + hstep, voffA);
            PG8_WAIT_L(8); PG8_BAR; PG8_WAIT_L(0); PG8_MMA(0, 0, At, B0); PG8_BAR; PG8_SCHED;
            PG8_LDB(B1, 1, 1); PG8_STAGE(PG8_SB(1, 0), b3, voffB);
            PG8_BAR; PG8_WAIT_L(0); PG8_MMA(0, 1, At, B1); PG8_BAR;
            PG8_LDA(At, 1, 1); PG8_STAGE(PG8_SA(1, 0), a3, voffA);
            PG8_BAR; PG8_WAIT_L(0); PG8_MMA(1, 0, At, B0); PG8_BAR; PG8_SCHED;
            PG8_STAGE(PG8_SB(1, 1), b3 + hstep, voffB);
            PG8_WAIT_V(6); PG8_BAR; PG8_MMA(1, 1, At, B1); PG8_BAR;
            }
        }
        if constexpr (ALIGN_EPI) { if (wr == 0) PG8_BAR; }
        if constexpr (!Epi::AFTER_DRAIN) { E(acc, cur, wr, wc, fr, fq); S.done(cur); }
        if (!has_next) break;
#pragma unroll
        for (int a = 0; a < 2; ++a)
#pragma unroll
            for (int b = 0; b < 2; ++b)
#pragma unroll
                for (int m = 0; m < 4; ++m)
#pragma unroll
                    for (int n = 0; n < 2; ++n) acc[a][b][m][n] = (f32x4){0.f, 0.f, 0.f, 0.f};
        cur = nxt; cA = nA; cB = nB; ++ui;
        if constexpr (ALIGN_EPI) { if (wr == 1) PG8_BAR; }
    }
    PG8_WAIT_V(0);
    if constexpr (!ALIGN_EPI) { if (wr == 0) PG8_BAR; }
    PG8_BAR;
    if constexpr (Epi::AFTER_DRAIN) { E.fused(acc, cur, wr, wc, fr, fq, lds, wid, lane); S.done(cur); }
#undef PG8_SA
#undef PG8_SB
#undef PG8_STAGE
#undef PG8_LDA
#undef PG8_LDB
#undef PG8_MMA
#undef PG8_WAIT_V
#undef PG8_WAIT_L
#undef PG8_BAR
#undef PG8_SCHED
}
}
#define DI __device__ __forceinline__
#define LAS __attribute__((address_space(3)))
typedef unsigned short bf16;
typedef short bf16x8 __attribute__((ext_vector_type(8)));
typedef short s16x4 __attribute__((ext_vector_type(4)));
typedef float f32x4 __attribute__((ext_vector_type(4)));
typedef float f32x16 __attribute__((ext_vector_type(16)));
typedef unsigned u32x4 __attribute__((ext_vector_type(4)));
typedef unsigned u32x2 __attribute__((ext_vector_type(2)));
constexpr int D = 2048, BATCH = 4, SEQ = 8192, T = BATCH * SEQ, DEPTH = 2, MEMLEN = 256;
constexpr int PROJW = 6168, PROJN = 6400;
constexpr int QAP = 2304, PROJP = 4224;
constexpr int O_QA = 0, O_KA = 768, O_VA = 1536, O_QB = 0, O_KB = 512, O_VB = 1024, O_FL = 1536, O_QC = 1544, O_KC = 1928, O_VC = 2312, O_RC = 3080, O_GL = 3848;
constexpr int DFF = 5504, CW = 512;
constexpr float LOG2E = 1.4426950408889634f, EPS = 1e-6f;
constexpr int NWAVES = 8, NTHR = 512;
constexpr int LDS_BYTES = 150528;
constexpr size_t MiB = 1u << 20;
constexpr size_t WS_CTL = 0, WS_C2 = 1 * MiB, WS_DEC = 2 * MiB, WS_LSE = 3 * MiB, WS_MEMN = 8 * MiB, WS_KVC = 12 * MiB;
constexpr size_t WS_WIN = 16 * MiB, WS_WOUT = 41 * MiB, WS_WCQ = 49 * MiB, WS_WCKV = 51 * MiB, WS_WCO = 55 * MiB, WS_WUP = 57 * MiB, WS_WDOWN = 100 * MiB;
constexpr size_t WS_XN = 122 * MiB, WS_QKVA = 250 * MiB, WS_PROJ = 394 * MiB, WS_ACT = 266 * MiB, WS_QC = 266 * MiB, WS_OC = 298 * MiB;
constexpr size_t WS_MIXED = 666 * MiB, WS_SC = 794 * MiB, WS_GL = 794 * MiB, WS_GF = 816 * MiB, WS_VF = 838 * MiB, WS_END = 938 * MiB;

DI float wave_sum(float v) {
#pragma unroll
    for (int o = 1; o < 64; o <<= 1) v += __shfl_xor(v, o);
    return v;
}
DI unsigned f2bf(float f) { unsigned u = __builtin_bit_cast(unsigned, f); return (u + 0x7fffu + ((u >> 16) & 1u)) >> 16; }
DI unsigned pk2(float lo, float hi) { return f2bf(lo) | (f2bf(hi) << 16); }
DI float bf2f(unsigned short b) { return __builtin_bit_cast(float, (unsigned)b << 16); }
DI float bflo(unsigned w) { return __builtin_bit_cast(float, w << 16); }
DI float bfhi(unsigned w) { return __builtin_bit_cast(float, w & 0xffff0000u); }
DI float logsig(float x) { return fminf(x, 0.f) - log1pf(expf(-fabsf(x))); }
DI int crow(int r, int hi) { return (r & 3) + 8 * (r >> 2) + 4 * hi; }
#define MFMA32(a, b, c) __builtin_amdgcn_mfma_f32_32x32x16_bf16((a), (b), (c), 0, 0, 0)
typedef short v4i16_t __attribute__((ext_vector_type(4)));
DI s16x4 trd(const LAS char* p) { return __builtin_bit_cast(s16x4, __builtin_amdgcn_ds_read_tr16_b64_v4i16((LAS v4i16_t*)p)); }
DI bf16x8 frag_row(const LAS char* base, int pitch, int row0, int k0, int lane) { return *(const LAS bf16x8*)(base + (row0 + (lane & 31)) * pitch + (k0 + 8 * (lane >> 5)) * 2); }
DI bf16x8 frag_tr(const LAS char* base, int pitch, int k0, int col0, int lane) {
    const int h = lane >> 5, blk = (lane >> 4) & 1, q = (lane & 15) >> 2, p = lane & 3;
    const LAS char* a = base + (k0 + 8 * h + q) * pitch + (col0 + 16 * blk) * 2 + 8 * p;
    const s16x4 lo = trd(a), hi = trd(a + 4 * pitch);
    return __builtin_shufflevector(lo, hi, 0, 1, 2, 3, 4, 5, 6, 7);
}
DI bf16x8 frag_tr_perm(const LAS char* base, int pitch, int k0, int col0, int lane) {
    const int h = lane >> 5, blk = (lane >> 4) & 1, q = (lane & 15) >> 2, p = lane & 3;
    const LAS char* a = base + (k0 + 4 * h + q) * pitch + (col0 + 16 * blk) * 2 + 8 * p;
    const s16x4 lo = trd(a), hi = trd(a + 8 * pitch);
    return __builtin_shufflevector(lo, hi, 0, 1, 2, 3, 4, 5, 6, 7);
}
typedef float f32x2_t __attribute__((ext_vector_type(2))); typedef __bf16 bf16x2_t __attribute__((ext_vector_type(2)));
DI unsigned cvtpk(float lo, float hi) { f32x2_t v = {lo, hi}; bf16x2_t b = __builtin_convertvector(v, bf16x2_t); return __builtin_bit_cast(unsigned, b); }
DI bf16x8 pack8(const f32x16& x, int s) { u32x4 p; p[0] = cvtpk(x[8 * s], x[8 * s + 1]); p[1] = cvtpk(x[8 * s + 2], x[8 * s + 3]); p[2] = cvtpk(x[8 * s + 4], x[8 * s + 5]); p[3] = cvtpk(x[8 * s + 6], x[8 * s + 7]); return __builtin_bit_cast(bf16x8, p); }

struct AttnU {
    const bf16* Qb; long qstride; const bf16* Kb; const bf16* Vb; long kstride; bf16* Ob; long ostride;
    int NT, t_begin;
    const float* cq; const float* ck; int q0;
    float* lse; long lstride;
};
template <int DH, int MODE>
DI void attn_unit(LAS char* lds, const AttnU& u, const LAS float* tbl) {
    constexpr int PITCH = DH * 2 + 16, TILEB = 64 * PITCH, BUFB = 2 * TILEB + 256, NCH = DH / 8, PER = NCH / 8;
    const int tid = otid(), lane = tid & 63, r32 = lane & 31, hi = lane >> 5; const int w = __builtin_amdgcn_readfirstlane(tid >> 6);
    bf16x8 qf[DH / 16];
    { const bf16* qrow = u.Qb + (long)(32 * w + r32) * u.qstride;
#pragma unroll
      for (int d0 = 0; d0 < DH / 16; ++d0) qf[d0] = *(const bf16x8*)(qrow + 16 * d0 + 8 * hi); }
    f32x16 o[DH / 32];
#pragma unroll
    for (int i = 0; i < DH / 32; ++i)
#pragma unroll
        for (int r = 0; r < 16; ++r) o[i][r] = 0.f;
    float m = -INFINITY, l = 0.f;
    u32x4 kreg[PER], vreg[PER]; float ckreg = 0.f;
    const int srow = (tid * PER) / NCH, sch = (tid * PER) % NCH;
#define AT_GLOAD(t) do { const long rr_ = (long)(64 * (t) + srow) * u.kstride + sch * 8; \
        _Pragma("unroll") for (int i_ = 0; i_ < PER; ++i_) { kreg[i_] = *(const u32x4*)(u.Kb + rr_ + 8 * i_); vreg[i_] = *(const u32x4*)(u.Vb + rr_ + 8 * i_); } \
        if (MODE == 1 && tid < 64) ckreg = u.ck[64 * (t) + tid]; } while (0)
#define AT_LWRITE(buf) do { LAS char* kb_ = lds + (buf) * BUFB + srow * PITCH + sch * 16; \
        _Pragma("unroll") for (int i_ = 0; i_ < PER; ++i_) { *(LAS u32x4*)(kb_ + 16 * i_) = kreg[i_]; *(LAS u32x4*)(kb_ + TILEB + 16 * i_) = vreg[i_]; } \
        if (MODE == 1 && tid < 64) *(LAS float*)(lds + (buf) * BUFB + 2 * TILEB + 4 * tid) = ckreg; } while (0)
    const int t0 = u.t_begin, NT = u.NT;
    AT_GLOAD(t0); AT_LWRITE(0); __syncthreads();
    for (int t = t0; t < NT; ++t) {
        const int cur = (t - t0) & 1;
        if (t + 1 < NT) AT_GLOAD(t + 1);
        const LAS char* Kt = lds + cur * BUFB; const LAS char* Vt = Kt + TILEB; const LAS float* ckl = (const LAS float*)(Kt + 2 * TILEB);
#pragma unroll
        for (int sub = 0; sub < 2; ++sub) {
            const int s = 2 * t + sub;
            bool active = true;
            if (MODE == 1) active = (32 * s <= u.q0 + 32 * w + 31);
            if (MODE == 2) active = (s >= w && s <= w + 4);
            if (active) {
                f32x16 p;
#pragma unroll
                for (int r = 0; r < 16; ++r) p[r] = 0.f;
#pragma unroll
                for (int d0 = 0; d0 < DH / 16; ++d0) { const bf16x8 kf = frag_row(Kt, PITCH, 32 * sub, 16 * d0, lane); p = MFMA32(kf, qf[d0], p); }
                if (MODE == 1) {
                    const bool diag = (32 * s + 31 > u.q0 + 32 * w);
                    const int qa = u.q0 + 32 * w + r32, kb = 32 * s + 4 * hi;
#pragma unroll
                    for (int g = 0; g < 4; ++g) { const f32x4 c4 = *(const LAS f32x4*)(ckl + 32 * sub + 8 * g + 4 * hi);
#pragma unroll
                        for (int e = 0; e < 4; ++e) p[4 * g + e] -= c4[e]; }
                    if (diag) {
#pragma unroll
                        for (int r = 0; r < 16; ++r) { const int ka = kb + (r & 3) + 8 * (r >> 2); p[r] = (ka <= qa) ? p[r] : -INFINITY; } }
                }
                if (MODE == 2) {
                    const LAS float* tb = tbl + (32 + 128 + 32 * w + r32 - 32 * s - 4 * hi);
#pragma unroll
                    for (int r = 0; r < 16; ++r) p[r] += tb[-((r & 3) + 8 * (r >> 2))];
                }
                float mx = p[0];
#pragma unroll
                for (int r = 1; r < 16; ++r) mx = fmaxf(mx, p[r]);
                mx = fmaxf(mx, __shfl_xor(mx, 32));
                const float mn = fmaxf(m, mx);
                if (__any(mn > m)) {
                    const float mr_ = (mn == -INFINITY) ? 0.f : mn;
                    const float alpha = __builtin_amdgcn_exp2f(m - mr_);
                    l *= alpha;
#pragma unroll
                    for (int i = 0; i < DH / 32; ++i)
#pragma unroll
                        for (int r = 0; r < 16; ++r) o[i][r] *= alpha;
                    m = mn;
                }
                const float mref = (m == -INFINITY) ? 0.f : m;
#pragma unroll
                for (int r = 0; r < 16; ++r) { p[r] = __builtin_amdgcn_exp2f(p[r] - mref); l += p[r]; }
                const bf16x8 pb0 = pack8(p, 0), pb1 = pack8(p, 1);
#pragma unroll
                for (int db = 0; db < DH / 32; ++db) {
                    const bf16x8 v0 = frag_tr_perm(Vt, PITCH, 32 * sub, 32 * db, lane), v1 = frag_tr_perm(Vt, PITCH, 32 * sub + 16, 32 * db, lane);
                    o[db] = MFMA32(v0, pb0, o[db]); o[db] = MFMA32(v1, pb1, o[db]);
                }
            }
        }
        if (t + 1 < NT) AT_LWRITE(cur ^ 1);
        __syncthreads();
    }
#undef AT_GLOAD
#undef AT_LWRITE
    l += __shfl_xor(l, 32);
    const float inv = 1.f / l;
    bf16* orow = u.Ob + (long)(32 * w + r32) * u.ostride;
#pragma unroll
    for (int db = 0; db < DH / 32; ++db)
#pragma unroll
        for (int g = 0; g < 4; ++g) { u32x2 wv; wv.x = cvtpk(o[db][4 * g] * inv, o[db][4 * g + 1] * inv); wv.y = cvtpk(o[db][4 * g + 2] * inv, o[db][4 * g + 3] * inv);
            *(u32x2*)(orow + 32 * db + 8 * g + 4 * hi) = wv; }
    if (MODE == 2 && hi == 0) u.lse[(long)(32 * w + r32) * u.lstride] = m + __log2f(l);
}
DI void norm_row_bf16(const float* xrow, const float* g, bf16* orow, int lane) {
    const f32x4* xr = (const f32x4*)xrow + lane; const f32x4* gr = (const f32x4*)g + lane;
    f32x4 v[8]; float s = 0.f;
#pragma unroll
    for (int j = 0; j < 8; ++j) { v[j] = xr[64 * j]; s += (v[j].x * v[j].x + v[j].y * v[j].y) + (v[j].z * v[j].z + v[j].w * v[j].w); }
    const float rstd = 1.f / sqrtf(wave_sum(s) * (1.f / D) + EPS);
    u32x2* o8 = (u32x2*)orow + lane;
#pragma unroll
    for (int j = 0; j < 8; ++j) { const f32x4 gg = gr[64 * j]; u32x2 w; w.x = pk2(v[j].x * rstd * gg.x, v[j].y * rstd * gg.y); w.y = pk2(v[j].z * rstd * gg.z, v[j].w * rstd * gg.w); o8[64 * j] = w; }
}
DI void xconv_row(const float* xrow, bf16* orow, unsigned long long* ssrow, int lane) {
    const f32x4* xr = (const f32x4*)xrow + lane;
    f32x4 v[8]; float s = 0.f;
#pragma unroll
    for (int j = 0; j < 8; ++j) { v[j] = xr[64 * j]; s += (v[j].x * v[j].x + v[j].y * v[j].y) + (v[j].z * v[j].z + v[j].w * v[j].w); }
    s = wave_sum(s); if (lane == 0) *ssrow = (unsigned long long)(s * 262144.f + 0.5f);
    u32x2* o8 = (u32x2*)orow + lane;
#pragma unroll
    for (int j = 0; j < 8; ++j) { u32x2 w; w.x = pk2(v[j].x, v[j].y); w.y = pk2(v[j].z, v[j].w); o8[64 * j] = w; }
}
DI void norm_row_out(const bf16* xrow, const float* g, float* orow, int lane) {
    const u32x4* xr = (const u32x4*)xrow + lane; const f32x4* gr = (const f32x4*)g; f32x4* o4 = (f32x4*)orow;
    float v[32]; float s = 0.f;
#pragma unroll
    for (int j = 0; j < 4; ++j) { const u32x4 w = xr[64 * j];
#pragma unroll
        for (int q = 0; q < 4; ++q) { v[8 * j + 2 * q] = bflo(w[q]); v[8 * j + 2 * q + 1] = bfhi(w[q]); s += v[8 * j + 2 * q] * v[8 * j + 2 * q] + v[8 * j + 2 * q + 1] * v[8 * j + 2 * q + 1]; } }
    const float rstd = 1.f / sqrtf(wave_sum(s) * (1.f / D) + EPS);
#pragma unroll
    for (int j = 0; j < 4; ++j) { const int c4 = (64 * j + lane) * 2;
        const f32x4 g0 = gr[c4], g1 = gr[c4 + 1];
        __builtin_nontemporal_store((f32x4){v[8 * j] * rstd * g0.x, v[8 * j + 1] * rstd * g0.y, v[8 * j + 2] * rstd * g0.z, v[8 * j + 3] * rstd * g0.w}, &o4[c4]);
        __builtin_nontemporal_store((f32x4){v[8 * j + 4] * rstd * g1.x, v[8 * j + 5] * rstd * g1.y, v[8 * j + 6] * rstd * g1.z, v[8 * j + 7] * rstd * g1.w}, &o4[c4 + 1]); }
}
DI float win_scale(int n) {
    if (n < 768) return 0.125f * LOG2E;
    if (n >= 2304 && n < 2816) return 0.125f * LOG2E;
    if (n >= 3848 && n < 4232) return 0.10206207261596575f;
    return 1.f;
}
template <int MODE>
DI void wt_item(const float* W, int K, int N, bf16* WT, LAS float* scr, int item, int nblk, float sc, const float* gk, int lane) {
    const int kb = item / nblk, nb = item % nblk, k0 = 64 * kb, nd0 = 32 * nb;
    int ns0 = nd0;
    if (MODE == 2) { const int pn = nd0 >> 8, bj = (nd0 >> 7) & 1, j = nd0 & 127; ns0 = bj * DFF + 128 * pn + j; }
    { const int n4 = (lane & 7) * 4, nsrc = ns0 + n4; const bool ok = nsrc < N;
      f32x4 v[8];
#pragma unroll
      for (int i = 0; i < 8; ++i) { const int kk = (lane >> 3) + 8 * i; v[i] = ok ? *(const f32x4*)(W + (size_t)(k0 + kk) * N + nsrc) : (f32x4){0.f, 0.f, 0.f, 0.f}; }
#pragma unroll
      for (int i = 0; i < 8; ++i) { const int kk = (lane >> 3) + 8 * i; const float gsc = gk ? gk[k0 + kk] : 1.f; LAS float* d = scr + kk * 33 + n4;
          d[0] = v[i].x * gsc; d[1] = v[i].y * gsc; d[2] = v[i].z * gsc; d[3] = v[i].w * gsc; } }
    asm volatile("s_waitcnt lgkmcnt(0)" ::: "memory");
    const int c = lane & 7;
#pragma unroll
    for (int j = 0; j < 4; ++j) { const int n = (lane >> 3) + 8 * j; const LAS float* s = scr + (8 * c) * 33 + n;
        float f = sc; if (MODE == 1) f = win_scale(nd0 + n);
        u32x4 o; o.x = pk2(s[0 * 33] * f, s[1 * 33] * f); o.y = pk2(s[2 * 33] * f, s[3 * 33] * f); o.z = pk2(s[4 * 33] * f, s[5 * 33] * f); o.w = pk2(s[6 * 33] * f, s[7 * 33] * f);
        *(u32x4*)(WT + (size_t)(nd0 + n) * K + k0 + 8 * c) = o; }
    asm volatile("s_waitcnt lgkmcnt(0)" ::: "memory");
}
DI float logsig_fast(float x) { return fminf(x, 0.f) - __logf(1.f + __expf(-fabsf(x))); }
DI void fscan_chunk(LAS char* lds, int c, const bf16* PROJ, const float* fbias, float* C2, float* TOT) {
    LAS float* vals = (LAS float*)lds;
    const int tid = otid(), lane = tid & 63, w = tid >> 6;
    { const int t = tid >> 2, hq = tid & 3;
      const unsigned v = *(const unsigned*)(PROJ + ((size_t)c * 128 + t) * PROJP + O_FL + 2 * hq);
      vals[(2 * hq) * 128 + t] = logsig_fast(bflo(v) + fbias[2 * hq]) * LOG2E; vals[(2 * hq + 1) * 128 + t] = logsig_fast(bfhi(v) + fbias[2 * hq + 1]) * LOG2E; }
    __syncthreads();
    { const float a0 = vals[w * 128 + 2 * lane], a1 = vals[w * 128 + 2 * lane + 1]; const float sum = a0 + a1;
      float inc = sum;
#pragma unroll
      for (int o = 1; o < 64; o <<= 1) { const float nb = __shfl_up(inc, o); if (lane >= o) inc += nb; }
      const float ex = inc - sum;
      const int b = c >> 6, tb = (c & 63) * 128 + 2 * lane;
      float* dst = C2 + ((size_t)b * 8 + w) * SEQ + tb; dst[0] = ex + a0; dst[1] = ex + sum;
      if (lane == 63) TOT[c * 8 + w] = inc; }
    __syncthreads();
}
constexpr int G_OF = 0, G_BL = 0, G_QT = 49152, G_KT = 62464, G_VT = 75776, G_AM = 101376, G_SP = 110592, G_END = 148992;
constexpr int PQK = 208, PV = 400, PAM = 144;
static_assert(G_END <= LDS_BYTES, "gla lds");
template <int PH>
DI void gla_unit(LAS char* lds, int unit, const bf16* PROJ, const float* W2, const float* gb, bf16* SC, float* DEC, const float* cnorm, bf16* MIXED, bf16* QG, bf16* KG) {
    const int tid = otid(), lane = tid & 63, r32 = lane & 31, hi = lane >> 5; const int w = __builtin_amdgcn_readfirstlane(tid >> 6);
    const int bh = unit >> 7, n = unit & 127, b = bh >> 2, h = bh & 3;
    const size_t row0 = (size_t)b * SEQ + 64 * n;
    const int t = tid >> 3, kg = tid & 7;
    if (PH == 1) {
        LAS float* BL = (LAS float*)(lds + G_BL);
        u32x2 kv[3], qv[3];
        { const bf16* kp = PROJ + (row0 + t) * PROJP + O_KC + 96 * h + 12 * kg; const bf16* qp = PROJ + (row0 + t) * PROJP + O_QC + 96 * h + 12 * kg;
#pragma unroll
          for (int j = 0; j < 3; ++j) { kv[j] = *(const u32x2*)(kp + 4 * j); qv[j] = *(const u32x2*)(qp + 4 * j); } }
#pragma unroll
        for (int j = 0; j < 3; ++j) { const int c = tid + NTHR * j, tt = c / 24, ch = c - 24 * tt;
            *(LAS u32x4*)(lds + G_VT + tt * PV + ch * 16) = *(const u32x4*)(PROJ + (row0 + tt) * PROJP + O_VC + 192 * h + 8 * ch); }
        if (w < 3) {
            const int k = 32 * w + r32;
            bf16x8 bw; { u32x4 pw;
#pragma unroll
                for (int j = 0; j < 4; ++j) pw[j] = pk2(W2[(8 * hi + 2 * j) * 384 + 96 * h + k], W2[(8 * hi + 2 * j + 1) * 384 + 96 * h + k]);
                bw = __builtin_bit_cast(bf16x8, pw); }
            const float gbias = gb[96 * h + k];
            float carry = 0.f;
#pragma unroll
            for (int mi = 0; mi < 2; ++mi) {
                const bf16x8 ga = *(const bf16x8*)(PROJ + (row0 + 32 * mi + r32) * PROJP + O_GL + 8 * hi);
                f32x16 d;
#pragma unroll
                for (int r = 0; r < 16; ++r) d[r] = 0.f;
                d = MFMA32(ga, bw, d);
#pragma unroll
                for (int r = 0; r < 16; ++r) d[r] = logsig_fast(d[r] + gbias) * 0.0625f;
                float sg[4], ps[4];
#pragma unroll
                for (int g = 0; g < 4; ++g) { d[4 * g + 1] += d[4 * g]; d[4 * g + 2] += d[4 * g + 1]; d[4 * g + 3] += d[4 * g + 2]; sg[g] = d[4 * g + 3]; }
#pragma unroll
                for (int g = 0; g < 4; ++g) ps[g] = __shfl_xor(sg[g], 32);
                float base_ = carry;
#pragma unroll
                for (int g = 0; g < 4; ++g) { const float off = base_ + (hi ? ps[g] : 0.f);
#pragma unroll
                    for (int e = 0; e < 4; ++e) d[4 * g + e] += off;
                    base_ += sg[g] + ps[g]; }
                carry = base_;
#pragma unroll
                for (int r = 0; r < 16; ++r) BL[(32 * mi + crow(r, hi)) * 96 + k] = d[r];
            }
        }
        __syncthreads();
        { bf16* qg = QG + (row0 + t) * 384 + 96 * h + 12 * kg; bf16* kgp = KG + (row0 + t) * 384 + 96 * h + 12 * kg;
#pragma unroll
          for (int j = 0; j < 3; ++j) {
              float bb[4], bl[4];
#pragma unroll
              for (int e = 0; e < 4; ++e) { bb[e] = BL[t * 96 + 12 * kg + 4 * j + e]; bl[e] = BL[63 * 96 + 12 * kg + 4 * j + e]; }
              const float k0 = bflo(kv[j].x), k1 = bfhi(kv[j].x), k2 = bflo(kv[j].y), k3 = bfhi(kv[j].y);
              u32x2 o; o.x = pk2(k0 * __expf(bl[0] - bb[0]), k1 * __expf(bl[1] - bb[1])); o.y = pk2(k2 * __expf(bl[2] - bb[2]), k3 * __expf(bl[3] - bb[3]));
              *(LAS u32x2*)(lds + G_KT + t * PQK + (12 * kg + 4 * j) * 2) = o;
              u32x2 ok; ok.x = pk2(k0 * __expf(-bb[0]), k1 * __expf(-bb[1])); ok.y = pk2(k2 * __expf(-bb[2]), k3 * __expf(-bb[3]));
              *(u32x2*)(kgp + 4 * j) = ok;
              u32x2 oq; oq.x = pk2(bflo(qv[j].x) * __expf(bb[0]), bfhi(qv[j].x) * __expf(bb[1])); oq.y = pk2(bflo(qv[j].y) * __expf(bb[2]), bfhi(qv[j].y) * __expf(bb[3]));
              *(u32x2*)(qg + 4 * j) = oq;
          } }
        if (tid < 96) DEC[(size_t)unit * 96 + tid] = __expf(BL[63 * 96 + tid]);
        __syncthreads();
        bf16* dst = SC + (size_t)unit * 18432;
        for (int tile = w; tile < 18; tile += 8) { const int mi = tile / 6, ni = tile - 6 * mi;
            f32x16 c;
#pragma unroll
            for (int r = 0; r < 16; ++r) c[r] = 0.f;
#pragma unroll
            for (int s = 0; s < 4; ++s) { const bf16x8 a = frag_tr(lds + G_KT, PQK, 16 * s, 32 * mi, lane), bq = frag_tr(lds + G_VT, PV, 16 * s, 32 * ni, lane); c = MFMA32(a, bq, c); }
#pragma unroll
            for (int g = 0; g < 4; ++g) { u32x2 o; o.x = pk2(c[4 * g], c[4 * g + 1]); o.y = pk2(c[4 * g + 2], c[4 * g + 3]);
                *(u32x2*)(dst + (32 * ni + r32) * 96 + 32 * mi + 8 * g + 4 * hi) = o; } }
    } else {
        { const bf16* qg = QG + (row0 + t) * 384 + 96 * h + 12 * kg; const bf16* kgp = KG + (row0 + t) * 384 + 96 * h + 12 * kg;
#pragma unroll
          for (int j = 0; j < 3; ++j) { *(LAS u32x2*)(lds + G_QT + t * PQK + (12 * kg + 4 * j) * 2) = *(const u32x2*)(qg + 4 * j); *(LAS u32x2*)(lds + G_KT + t * PQK + (12 * kg + 4 * j) * 2) = *(const u32x2*)(kgp + 4 * j); } }
#pragma unroll
        for (int j = 0; j < 3; ++j) { const int c = tid + NTHR * j, tt = c / 24, ch = c - 24 * tt;
            *(LAS u32x4*)(lds + G_VT + tt * PV + ch * 16) = *(const u32x4*)(PROJ + (row0 + tt) * PROJP + O_VC + 192 * h + 8 * ch); }
        const bf16* src = SC + (size_t)unit * 18432;
#pragma unroll
        for (int j = 0; j < 5; ++j) { const int c = tid + NTHR * j; if (c < 2304) *(LAS u32x4*)(lds + G_SP + c * 16) = *(const u32x4*)(src + c * 8); }
        __syncthreads();
        if (w < 4) { const int mi = w >> 1, nj = w & 1;
            f32x16 c;
#pragma unroll
            for (int r = 0; r < 16; ++r) c[r] = 0.f;
#pragma unroll
            for (int s = 0; s < 6; ++s) { const bf16x8 a = frag_row(lds + G_QT, PQK, 32 * mi, 16 * s, lane), bq = frag_row(lds + G_KT, PQK, 32 * nj, 16 * s, lane); c = MFMA32(a, bq, c); }
#pragma unroll
            for (int r = 0; r < 16; ++r) { const int i = 32 * mi + crow(r, hi), j = 32 * nj + r32; const float val = (j <= i) ? c[r] : 0.f;
                *(LAS unsigned short*)(lds + G_AM + i * PAM + j * 2) = (unsigned short)f2bf(val); } }
        __syncthreads();
        LAS float* OF = (LAS float*)(lds + G_OF);
        for (int tile = w; tile < 12; tile += 8) { const int mi = tile / 6, ni = tile - 6 * mi;
            f32x16 c;
#pragma unroll
            for (int r = 0; r < 16; ++r) c[r] = 0.f;
#pragma unroll
            for (int s = 0; s < 6; ++s) { const bf16x8 a = frag_row(lds + G_QT, PQK, 32 * mi, 16 * s, lane), bq = frag_row(lds + G_SP, 192, 32 * ni, 16 * s, lane); c = MFMA32(a, bq, c); }
#pragma unroll
            for (int s = 0; s < 4; ++s) { const bf16x8 a = frag_row(lds + G_AM, PAM, 32 * mi, 16 * s, lane), bq = frag_tr(lds + G_VT, PV, 16 * s, 32 * ni, lane); c = MFMA32(a, bq, c); }
#pragma unroll
            for (int r = 0; r < 16; ++r) OF[(32 * mi + crow(r, hi)) * 192 + 32 * ni + r32] = c[r]; }
        __syncthreads();
        { const int i = tid >> 3, part = tid & 7;
          const LAS float* orow = OF + i * 192 + 24 * part;
          float ov[24]; float ss = 0.f;
#pragma unroll
          for (int j = 0; j < 24; ++j) { ov[j] = orow[j]; ss += ov[j] * ov[j]; }
          ss += __shfl_xor(ss, 1); ss += __shfl_xor(ss, 2); ss += __shfl_xor(ss, 4);
          const float rstd = 1.f / sqrtf(ss * (1.f / 192.f) + EPS);
          const bf16* rcp = PROJ + (row0 + i) * PROJP + O_RC + 192 * h + 24 * part;
          bf16* op = MIXED + (row0 + i) * D + 1280 + 192 * h + 24 * part;
          const float* cn = cnorm + 24 * part;
#pragma unroll
          for (int q = 0; q < 3; ++q) { const u32x4 rv = *(const u32x4*)(rcp + 8 * q); u32x4 o;
#pragma unroll
              for (int e = 0; e < 4; ++e) { const float r0 = bflo(rv[e]), r1 = bfhi(rv[e]);
                  const float y0 = ov[8 * q + 2 * e] * rstd * cn[8 * q + 2 * e] * (r0 / (1.f + __expf(-r0))), y1 = ov[8 * q + 2 * e + 1] * rstd * cn[8 * q + 2 * e + 1] * (r1 / (1.f + __expf(-r1)));
                  o[e] = pk2(y0, y1); }
              *(u32x4*)(op + 8 * q) = o; } }
    }
    __syncthreads();
}
struct DilU { const bf16* Qb; const bf16* Kb; bf16* Ob; float* lse; int qstride, kstride, ostride, lstride, row_lo; };
constexpr int DIL_PITCH = 144, DIL_KB = 0, DIL_VB = 384 * DIL_PITCH;
static_assert(2 * 384 * DIL_PITCH + 36 * 192 * 4 <= 149504, "dilated lds");
struct DilRegs { u32x4 k[6], v[6]; bf16x8 q[4]; };
constexpr int DIL_TBLS = 2 * 384 * DIL_PITCH;
#define DIL_GLOAD(U, RG) do { _Pragma("unroll") for (int i_ = 0; i_ < 6; ++i_) { const int c_ = tid + NTHR * i_, row_ = c_ >> 3, ch_ = c_ & 7; \
        if (row_ >= (U).row_lo) { const bf16* p_ = (U).Kb + (long)row_ * (U).kstride + 8 * ch_; RG.k[i_] = *(const u32x4*)p_; RG.v[i_] = *(const u32x4*)(p_ + (O_VA - O_KA)); } } \
        { const bf16* qrow_ = (U).Qb + (long)(tid >> 1 & ~31 | (tid & 31)) * (U).qstride; _Pragma("unroll") for (int d0_ = 0; d0_ < 4; ++d0_) RG.q[d0_] = *(const bf16x8*)(qrow_ + 16 * d0_ + 8 * ((tid >> 5) & 1)); } } while (0)
#define DIL_LWRITE(RG) do { _Pragma("unroll") for (int i_ = 0; i_ < 6; ++i_) { const int c_ = tid + NTHR * i_, row_ = c_ >> 3, ch_ = c_ & 7; \
        *(LAS u32x4*)(lds + DIL_KB + row_ * DIL_PITCH + 16 * ch_) = RG.k[i_]; *(LAS u32x4*)(lds + DIL_VB + row_ * DIL_PITCH + 16 * ch_) = RG.v[i_]; } } while (0)
DI void dil_compute(LAS char* lds, const DilU& u, const LAS float* tbl, int tid, const bf16x8 (&qf)[4]) {
    const int lane = tid & 63, r32 = lane & 31, hi = lane >> 5; const int w = __builtin_amdgcn_readfirstlane(tid >> 6);
    f32x16 o[2];
#pragma unroll
    for (int i = 0; i < 2; ++i)
#pragma unroll
        for (int r = 0; r < 16; ++r) o[i][r] = 0.f;
    float m = -INFINITY, l = 0.f;
    for (int a = 0; a < 5; ++a) {
        const int s = w + a;
        if (32 * s < u.row_lo) continue;
        const LAS char* Kt = lds + DIL_KB + 32 * s * DIL_PITCH; const LAS char* Vt = lds + DIL_VB + 32 * s * DIL_PITCH;
        f32x16 p;
#pragma unroll
        for (int r = 0; r < 16; ++r) p[r] = 0.f;
#pragma unroll
        for (int d0 = 0; d0 < 4; ++d0) { const bf16x8 kf = frag_row(Kt, DIL_PITCH, 0, 16 * d0, lane); p = MFMA32(kf, qf[d0], p); }
        { const LAS float* tb = tbl + (32 + 128 + r32 - 32 * a - 4 * hi);
#pragma unroll
          for (int r = 0; r < 16; ++r) p[r] += tb[-((r & 3) + 8 * (r >> 2))]; }
        float mx = p[0];
#pragma unroll
        for (int r = 1; r < 16; ++r) mx = fmaxf(mx, p[r]);
        mx = fmaxf(mx, __shfl_xor(mx, 32));
        const float mn = fmaxf(m, mx);
        if (__any(mn > m)) {
            const float mr_ = (mn == -INFINITY) ? 0.f : mn;
            const float alpha = __builtin_amdgcn_exp2f(m - mr_);
            l *= alpha;
#pragma unroll
            for (int i = 0; i < 2; ++i)
#pragma unroll
                for (int r = 0; r < 16; ++r) o[i][r] *= alpha;
            m = mn;
        }
        const float mref = (m == -INFINITY) ? 0.f : m;
#pragma unroll
        for (int r = 0; r < 16; ++r) { p[r] = __builtin_amdgcn_exp2f(p[r] - mref); l += p[r]; }
        const bf16x8 pb0 = pack8(p, 0), pb1 = pack8(p, 1);
#pragma unroll
        for (int db = 0; db < 2; ++db) {
            const bf16x8 v0 = frag_tr_perm(Vt, DIL_PITCH, 0, 32 * db, lane), v1 = frag_tr_perm(Vt, DIL_PITCH, 16, 32 * db, lane);
            o[db] = MFMA32(v0, pb0, o[db]); o[db] = MFMA32(v1, pb1, o[db]);
        }
    }
    l += __shfl_xor(l, 32);
    const float inv = 1.f / l;
    bf16* orow = u.Ob + (long)(32 * w + r32) * u.ostride;
#pragma unroll
    for (int db = 0; db < 2; ++db)
#pragma unroll
        for (int g = 0; g < 4; ++g) { u32x2 wv; wv.x = cvtpk(o[db][4 * g] * inv, o[db][4 * g + 1] * inv); wv.y = cvtpk(o[db][4 * g + 2] * inv, o[db][4 * g + 3] * inv);
            *(u32x2*)(orow + 32 * db + 8 * g + 4 * hi) = wv; }
    if (hi == 0) u.lse[(long)(32 * w + r32) * u.lstride] = m + __log2f(l);
}
#include <hip/hip_bf16.h>
namespace attn_body {
using bf16=__hip_bfloat16;
using bf16x8=__attribute__((ext_vector_type(8)))short;
using s16x4=__attribute__((ext_vector_type(4)))short;
using f32x16=__attribute__((ext_vector_type(16)))float;
using u32x4=__attribute__((ext_vector_type(4)))unsigned;
constexpr int SEQ=8192,D=64,DM=4224,DMO=2048;
constexpr int NW=8,QBLK=32,QB=QBLK*NW,KVBLK=64,NQB=SEQ/QB;
__device__ __forceinline__ int crow(int r,int hi){return (r&3)+8*(r>>2)+4*hi;}
#define SBAR() __builtin_amdgcn_sched_barrier(0)
__device__ __forceinline__ void cmask(f32x16&p0,f32x16&p1,int jb,int qrel,int hi){
  const float NEG=-INFINITY; int kb=64*jb+4*hi;
  #pragma unroll
  for(int r=0;r<16;++r){int kv=kb+(r&3)+8*(r>>2); if(kv>qrel)p0[r]=NEG; if(kv+32>qrel)p1[r]=NEG;}
}

constexpr int NSLOT=3, SLOTB=8192;
constexpr int LDS_K=0, LDS_V=NSLOT*SLOTB, LDS_WS=2*NSLOT*SLOTB, LDS_OST=LDS_WS+NW*64*4, LDS_CK=LDS_OST+NW*4096, LDS_BYTES=LDS_CK+SEQ*4;
constexpr float C2=0.125f*1.4426950408889634f;
__device__ __forceinline__ void glds16(const void*gsrc,unsigned lds_dst){unsigned keep;
  asm volatile("s_mov_b32 %0, m0\n\ts_mov_b32 m0, %2\n\ts_nop 0\n\tglobal_load_lds_dwordx4 %1, off\n\ts_mov_b32 m0, %0":"=&s"(keep):"v"(gsrc),"s"(lds_dst):"memory");}
__device__ __forceinline__ float max3f(float a,float b,float c){float r;asm("v_max3_f32 %0, %1, %2, %3":"=v"(r):"v"(a),"v"(b),"v"(c));return r;}
__device__ __forceinline__ float max2f(float a,float b){float r;asm("v_max_f32_e32 %0, %1, %2":"=v"(r):"v"(a),"v"(b));return r;}
__device__ __forceinline__ float fadd_s(float a,float b){float r;asm("v_add_f32_e32 %0, %1, %2":"=v"(r):"v"(a),"v"(b));return r;}
__device__ __forceinline__ float fsub_s(float a,float b){float r;asm("v_sub_f32_e32 %0, %1, %2":"=v"(r):"v"(a),"v"(b));return r;}
typedef float f32x2_t __attribute__((ext_vector_type(2))); typedef __bf16 bf16x2_t __attribute__((ext_vector_type(2)));
__device__ __forceinline__ unsigned cvtpk_s(float lo,float hi){f32x2_t v={lo,hi};bf16x2_t b=__builtin_convertvector(v,bf16x2_t);return __builtin_bit_cast(unsigned,b);}
#define WAIT_BAR(N) asm volatile("s_waitcnt vmcnt(" #N ") lgkmcnt(0)\n\ts_barrier":::"memory")

__device__ __forceinline__ void qkt(f32x16&p0,f32x16&p1,const char*Kslot,const bf16x8*qr,const f32x16&negm,int r32,int hi){
  const char*kb=Kslot+hi*1024+r32*16;
  #pragma unroll
  for(int d0=0;d0<4;++d0){
    const bf16x8 b0=*reinterpret_cast<const bf16x8*>(kb+d0*2048);
    const bf16x8 b1=*reinterpret_cast<const bf16x8*>(kb+d0*2048+512);
    if(d0==0){p0=__builtin_amdgcn_mfma_f32_32x32x16_bf16(b0,qr[0],negm,0,0,0);p1=__builtin_amdgcn_mfma_f32_32x32x16_bf16(b1,qr[0],negm,0,0,0);}
    else{p0=__builtin_amdgcn_mfma_f32_32x32x16_bf16(b0,qr[d0],p0,0,0,0);p1=__builtin_amdgcn_mfma_f32_32x32x16_bf16(b1,qr[d0],p1,0,0,0);}}
}
typedef __attribute__((address_space(3))) const char* lds_cptr;
typedef short v4i16_t __attribute__((ext_vector_type(4)));
__device__ __forceinline__ void kload8(bf16x8*kf,lds_cptr kp){
  kf[0]=*(const __attribute__((address_space(3))) bf16x8*)(kp);      kf[1]=*(const __attribute__((address_space(3))) bf16x8*)(kp+512);
  kf[2]=*(const __attribute__((address_space(3))) bf16x8*)(kp+2048); kf[3]=*(const __attribute__((address_space(3))) bf16x8*)(kp+2560);
  kf[4]=*(const __attribute__((address_space(3))) bf16x8*)(kp+4096); kf[5]=*(const __attribute__((address_space(3))) bf16x8*)(kp+4608);
  kf[6]=*(const __attribute__((address_space(3))) bf16x8*)(kp+6144); kf[7]=*(const __attribute__((address_space(3))) bf16x8*)(kp+6656);
}
__device__ __forceinline__ void kload2(bf16x8*kf,lds_cptr kp,int j){ kf[2*j]=*(const __attribute__((address_space(3))) bf16x8*)(kp+j*2048); kf[2*j+1]=*(const __attribute__((address_space(3))) bf16x8*)(kp+j*2048+512); }
__device__ __forceinline__ s16x4 vtr(lds_cptr p){ return __builtin_bit_cast(s16x4,__builtin_amdgcn_ds_read_tr16_b64_v4i16((__attribute__((address_space(3))) v4i16_t*)p)); }
__device__ __forceinline__ float rowmax(const f32x16&p0,const f32x16&p1){
  float a=max3f(p0[0],p0[1],p1[0]),b=max3f(p0[2],p0[3],p1[1]);a=max3f(a,p1[2],p1[3]);
  #pragma unroll
  for(int r=4;r<16;r+=4){a=max3f(a,p0[r],p0[r+1]);b=max3f(b,p0[r+2],p0[r+3]);a=max3f(a,p1[r],p1[r+1]);b=max3f(b,p1[r+2],p1[r+3]);}
  const float m=max2f(a,b);
  auto rr=__builtin_amdgcn_permlane32_swap(__float_as_uint(m),__float_as_uint(m),false,false);
  return max2f(__uint_as_float(rr[0]),__uint_as_float(rr[1]));
}
__device__ __forceinline__ void pv(f32x16*o,int vb,bf16x8 pa0,bf16x8 pa1,bf16x8 pa2,bf16x8 pa3){
  #pragma unroll
  for(int d0=0;d0<2;++d0){s16x4 lo[4],hi[4];
    #pragma unroll
    for(int ks=0;ks<4;++ks){
      asm volatile("ds_read_b64_tr_b16 %0,%1 offset:%c2":"=&v"(lo[ks]):"v"(vb),"i"(d0*4096+ks*1024):"memory");
      asm volatile("ds_read_b64_tr_b16 %0,%1 offset:%c2":"=&v"(hi[ks]):"v"(vb),"i"(d0*4096+ks*1024+512):"memory");}
    asm volatile("s_waitcnt lgkmcnt(0)":::"memory");SBAR();
    #define PK(k) (bf16x8){lo[k][0],lo[k][1],lo[k][2],lo[k][3],hi[k][0],hi[k][1],hi[k][2],hi[k][3]}
    o[d0]=__builtin_amdgcn_mfma_f32_32x32x16_bf16(pa0,PK(0),o[d0],0,0,0);
    o[d0]=__builtin_amdgcn_mfma_f32_32x32x16_bf16(pa1,PK(1),o[d0],0,0,0);
    o[d0]=__builtin_amdgcn_mfma_f32_32x32x16_bf16(pa2,PK(2),o[d0],0,0,0);
    o[d0]=__builtin_amdgcn_mfma_f32_32x32x16_bf16(pa3,PK(3),o[d0],0,0,0);
    #undef PK
  }
}

#ifndef ATTN_STORE16
#define ATTN_STORE16(p,v) (*(u32x4*)(p)=(v))
#endif
typedef float f32x4v __attribute__((ext_vector_type(4)));
template<int THRL> __device__ __forceinline__ void attn_unit(int b,int h,int qb,const bf16*Q,const bf16*__restrict__ K,const bf16*__restrict__ V,bf16*O,const float*__restrict__ ckg,const float*__restrict__ ckoff,int ts,char*shm){
  const int tid=otid(),lane=tid&63,r32=lane&31,hi=lane>>5; const int wid=__builtin_amdgcn_readfirstlane(tid>>6);
  const long rowbase=(long)b*SEQ; const int q0=qb*QB;
  const bf16*Qw=Q+(rowbase+q0+wid*QBLK)*DM+h*D;
  const bf16*Kh=K+(rowbase+(long)ts*KVBLK)*DM+h*D,*Vh=V+(rowbase+(long)ts*KVBLK)*DM+h*D;
  const lds_cptr shm3=(lds_cptr)shm;
  const unsigned lds0=(unsigned)(uintptr_t)shm;
  float*wsf=(float*)(shm+LDS_WS)+wid*64;
  const bf16*ksrc=Kh+(long)lane*DM+wid*8;
  const bf16*vsrc=Vh+(long)(16*(wid&3)+(lane>>2))*DM+(wid>>2)*32+(lane&3)*8;
  const unsigned kdst=lds0+LDS_K+wid*1024, vdst=lds0+LDS_V+wid*1024;
  #define DMA_K(t,slot) glds16(ksrc+(long)(t)*KVBLK*DM,(unsigned)__builtin_amdgcn_readfirstlane(kdst+(slot)))
  #define DMA_V(t,slot) glds16(vsrc+(long)(t)*KVBLK*DM,(unsigned)__builtin_amdgcn_readfirstlane(vdst+(slot)))
  const int vb0=(int)(lds0+LDS_V)+((lane>>4)&1)*32+(lane&3)*8+(4*hi+((lane&15)>>2))*64;
  const char*Kbase=shm+LDS_K; bf16x8 kf[8];
  const lds_cptr kp0=shm3+LDS_K+hi*1024+r32*16; const lds_cptr vp0=shm3+LDS_V+((lane>>4)&1)*32+(lane&3)*8+(4*hi+((lane&15)>>2))*64;
  const int NT=(q0+QB)/KVBLK-ts;
  { __attribute__((address_space(3))) float*ckw=(__attribute__((address_space(3))) float*)(shm3+LDS_CK); const int nck=NT*KVBLK, kofs=ts*KVBLK; float cv[16];
    _Pragma("unroll") for(int j_=0;j_<16;++j_){const int i=tid+NW*64*j_; cv[j_]=(i<nck)?ckg[i+kofs]+ckoff[((i+kofs)>>7)*8]:0.f;}
    _Pragma("unroll") for(int j_=0;j_<16;++j_){const int i=tid+NW*64*j_; if(i<nck)ckw[i]=cv[j_];} }
  DMA_K(0,0);DMA_V(0,0);DMA_K(1,SLOTB);
  bf16x8 qr[4];
  #pragma unroll
  for(int d0=0;d0<4;++d0)qr[d0]=*reinterpret_cast<const bf16x8*>(&Qw[(long)r32*DM+d0*16+hi*8]);
  float mhat=0.f,l_reg=0.f;f32x16 o[2];o[0]=f32x16{};o[1]=f32x16{};f32x16 negm=f32x16{};asm volatile("":"+v"(negm));
  const int qrel=wid*QBLK+r32;
  #define CMASK(P0,P1,t) do{int jb_=(t)-(NT-4); if(jb_>=0)cmask(P0,P1,jb_,qrel,hi);}while(0)
  const __attribute__((address_space(3))) float*ckl3=(const __attribute__((address_space(3))) float*)(shm3+LDS_CK)+4*hi;
  #define BIAS(P0,P1,t) do{ const __attribute__((address_space(3))) float*cb_=ckl3+64*(t); \
    _Pragma("unroll") for(int g_=0;g_<4;++g_){ const f32x4v a_=*(const __attribute__((address_space(3))) f32x4v*)(cb_+8*g_), b_=*(const __attribute__((address_space(3))) f32x4v*)(cb_+32+8*g_); \
      _Pragma("unroll") for(int e_=0;e_<4;++e_){ P0[4*g_+e_]-=a_[e_]; P1[4*g_+e_]-=b_[e_]; } } }while(0)
  bool resc=false;
  #define START(P0,P1) do{ const float rm=rowmax(P0,P1); resc=false; \
    { const float dl=rm; mhat=fadd_s(mhat,dl); \
      _Pragma("unroll") for(int r=0;r<16;++r){P0[r]=fsub_s(P0[r],dl);P1[r]=fsub_s(P1[r],dl);} \
      _Pragma("unroll") for(int r=0;r<16;++r)negm[r]=-mhat; asm volatile("":"+v"(negm)); } \
    _Pragma("unroll") for(int r=0;r<16;++r)P0[r]=__builtin_amdgcn_exp2f(P0[r]); }while(0)
  #define RESC() do{ if(resc){ asm volatile("s_waitcnt lgkmcnt(0)":::"memory"); \
      _Pragma("unroll") for(int d_=0;d_<2;++d_) _Pragma("unroll") for(int r=0;r<16;++r)o[d_][r]*=wsf[crow(r,hi)]; } }while(0)
  f32x16 pA0,pA1,pB0,pB1;
  int sl_prev=0,sl_cur=0,sl_next=SLOTB;
  #define ROT() do{sl_prev=sl_cur;sl_cur=sl_next;sl_next=(sl_next==(NSLOT-1)*SLOTB)?0:sl_next+SLOTB;}while(0)
  DMA_K(2,2*SLOTB);
  WAIT_BAR(3);
  qkt(pA0,pA1,Kbase,qr,negm,r32,hi);asm volatile("s_nop 15\n\ts_nop 7":"+v"(pA0),"+v"(pA1));CMASK(pA0,pA1,0);BIAS(pA0,pA1,0);
  START(pA0,pA1);
  _Pragma("unroll") for(int r=0;r<16;++r)pA1[r]=__builtin_amdgcn_exp2f(pA1[r]);
  WAIT_BAR(0);
  DMA_K(3,0);DMA_V(1,SLOTB);
  ROT();
  kload8(kf,kp0+sl_cur);
  WAIT_BAR(2);
  s16x4 vlo[8],vhi[8]; u32x4 pw0,pw1,pw2,pw3;
  #define PKW(P,B) cvtpk_s(P[B],P[B+1])
  #define PAF(k) __builtin_bit_cast(bf16x8,pw##k)
  #define VFR(i) (bf16x8){vlo[i][0],vlo[i][1],vlo[i][2],vlo[i][3],vhi[i][0],vhi[i][1],vhi[i][2],vhi[i][3]}
  #define PIN(x) asm volatile("":"+v"(x))
  #define MX3(a,b,c) __builtin_fmaxf(__builtin_fmaxf((a),(b)),(c))
  #define GAPA(MF,A0,A1,A2,A3,W0,W1,PW) do{ MF; sacc+=A0; sacc+=A1; sacc+=A2; sacc+=A3; PIN(sacc); W0; W1; PIN(PW); SBAR(); }while(0)
  #define EX(v) __builtin_amdgcn_exp2f(v)
  #define GAPB(MF,X,B) do{ MF; X[B]=EX(X[B]); X[B+1]=EX(X[B+1]); X[B+2]=EX(X[B+2]); X[B+3]=EX(X[B+3]); PIN(X); SBAR(); }while(0)
  #define VRD(i) do{ vlo[i]=vtr(vp_+(((i)>>2)*4096+((i)&3)*1024)); vhi[i]=vtr(vp_+(((i)>>2)*4096+((i)&3)*1024+512)); }while(0)
  #define KRD(G,j) do{ if(G){ kload2(kf,kp0+sl_next,j); SBAR(); } }while(0)
  #define STEP(C0,C1,P0,P1,t,GK,GV,GL) do{ SBAR(); \
    const lds_cptr vp_=vp0+sl_prev; \
    VRD(0); SBAR(); float sacc=(P0[0]+P0[1]); \
    GAPA(C0=__builtin_amdgcn_mfma_f32_32x32x16_bf16(kf[0],qr[0],negm,0,0,0), P0[2],P0[3],P0[4],P0[5],     pw0[0]=PKW(P0,0), pw0[1]=PKW(P0,2), pw0); \
    VRD(4); SBAR(); GAPA(C1=__builtin_amdgcn_mfma_f32_32x32x16_bf16(kf[1],qr[0],negm,0,0,0), P0[6],P0[7],P0[8],P0[9],     pw0[2]=PKW(P0,4), pw0[3]=PKW(P0,6), pw0); \
    VRD(1); SBAR(); GAPA(C0=__builtin_amdgcn_mfma_f32_32x32x16_bf16(kf[2],qr[1],C0,0,0,0),   P0[10],P0[11],P0[12],P0[13], pw1[0]=PKW(P0,8), pw1[1]=PKW(P0,10), pw1); \
    VRD(5); SBAR(); GAPA(C1=__builtin_amdgcn_mfma_f32_32x32x16_bf16(kf[3],qr[1],C1,0,0,0),   P0[14],P0[15],P1[0],P1[1],   pw1[2]=PKW(P0,12),pw1[3]=PKW(P0,14), pw1); \
    VRD(2); SBAR(); GAPA(C0=__builtin_amdgcn_mfma_f32_32x32x16_bf16(kf[4],qr[2],C0,0,0,0),   P1[2],P1[3],P1[4],P1[5],     pw2[0]=PKW(P1,0), pw2[1]=PKW(P1,2), pw2); \
    VRD(6); SBAR(); GAPA(C1=__builtin_amdgcn_mfma_f32_32x32x16_bf16(kf[5],qr[2],C1,0,0,0),   P1[6],P1[7],P1[8],P1[9],     pw2[2]=PKW(P1,4), pw2[3]=PKW(P1,6), pw2); \
    VRD(3); SBAR(); GAPA(C0=__builtin_amdgcn_mfma_f32_32x32x16_bf16(kf[6],qr[3],C0,0,0,0),   P1[10],P1[11],P1[12],P1[13], pw3[0]=PKW(P1,8), pw3[1]=PKW(P1,10), pw3); \
    VRD(7); SBAR(); GAPA(C1=__builtin_amdgcn_mfma_f32_32x32x16_bf16(kf[7],qr[3],C1,0,0,0),   P1[14],P1[15],0.f,0.f,       pw3[2]=PKW(P1,12),pw3[3]=PKW(P1,14), pw3); \
    l_reg+=sacc; \
    if(GK){DMA_K((t)+3,sl_cur);} if(GV){DMA_V((t)+1,sl_next);} \
    CMASK(C0,C1,t); BIAS(C0,C1,t); \
    { float a=MX3(C0[0],C0[1],C1[0]),b=MX3(C0[2],C0[3],C1[1]); a=MX3(a,C1[2],C1[3]); \
      _Pragma("unroll") for(int r=4;r<16;r+=4){a=MX3(a,C0[r],C0[r+1]);b=MX3(b,C0[r+2],C0[r+3]);a=MX3(a,C1[r],C1[r+1]);b=MX3(b,C1[r+2],C1[r+3]);} \
      float rm=__builtin_fmaxf(a,b); { auto rr=__builtin_amdgcn_permlane32_swap(__float_as_uint(rm),__float_as_uint(rm),false,false); rm=__builtin_fmaxf(__uint_as_float(rr[0]),__uint_as_float(rr[1])); } \
      resc=false; \
      if(__builtin_expect(__any(rm>(float)THRL),0)){ const float dl=__builtin_fmaxf(rm,0.f); mhat+=dl; \
        _Pragma("unroll") for(int r=0;r<16;++r){C0[r]-=dl;C1[r]-=dl;} \
        _Pragma("unroll") for(int r=0;r<16;++r)negm[r]=-mhat; asm volatile("":"+v"(negm)); \
        const float f=__builtin_amdgcn_exp2f(-dl); l_reg*=f; if(hi==0)wsf[r32]=f; resc=true; } } \
    SBAR(); \
    GAPB(o[0]=__builtin_amdgcn_mfma_f32_32x32x16_bf16(PAF(0),VFR(0),o[0],0,0,0), C0,0); \
    GAPB(o[1]=__builtin_amdgcn_mfma_f32_32x32x16_bf16(PAF(0),VFR(4),o[1],0,0,0), C0,4); \
    KRD(GL,0); GAPB(o[0]=__builtin_amdgcn_mfma_f32_32x32x16_bf16(PAF(1),VFR(1),o[0],0,0,0), C0,8); \
    KRD(GL,1); GAPB(o[1]=__builtin_amdgcn_mfma_f32_32x32x16_bf16(PAF(1),VFR(5),o[1],0,0,0), C0,12); \
    KRD(GL,2); GAPB(o[0]=__builtin_amdgcn_mfma_f32_32x32x16_bf16(PAF(2),VFR(2),o[0],0,0,0), C1,0); \
    KRD(GL,3); GAPB(o[1]=__builtin_amdgcn_mfma_f32_32x32x16_bf16(PAF(2),VFR(6),o[1],0,0,0), C1,4); \
    GAPB(o[0]=__builtin_amdgcn_mfma_f32_32x32x16_bf16(PAF(3),VFR(3),o[0],0,0,0), C1,8); \
    GAPB(o[1]=__builtin_amdgcn_mfma_f32_32x32x16_bf16(PAF(3),VFR(7),o[1],0,0,0), C1,12); \
    }while(0)
  int t=1;
  #undef CMASK
  #define CMASK(P0,P1,t) do{}while(0)
  for(;t+5<NT;t+=2){
    STEP(pB0,pB1,pA0,pA1,t,true,true,true);     WAIT_BAR(2); RESC(); ROT();
    STEP(pA0,pA1,pB0,pB1,t+1,true,true,true);   WAIT_BAR(2); RESC(); ROT();
  }
  #undef CMASK
  #define CMASK(P0,P1,t) do{int jb_=(t)-(NT-4); if(jb_>=0)cmask(P0,P1,jb_,qrel,hi);}while(0)
  #define ENDW(tt) do{ if((tt)+3<NT){WAIT_BAR(2);} else if((tt)+2<NT){WAIT_BAR(1);} else {WAIT_BAR(0);} }while(0)
  for(;t+1<NT;t+=2){
    STEP(pB0,pB1,pA0,pA1,t,(t+3<NT),(t+1<NT),(t+1<NT));       ENDW(t);   RESC(); ROT();
    STEP(pA0,pA1,pB0,pB1,t+1,(t+4<NT),(t+2<NT),(t+2<NT));     ENDW(t+1); RESC(); ROT();
  }
  STEP(pB0,pB1,pA0,pA1,NT-1,false,false,false); RESC();
  { float sacc=pB0[0]+pB0[1]; _Pragma("unroll") for(int r=2;r<16;++r)sacc+=pB0[r]; _Pragma("unroll") for(int r=0;r<16;++r)sacc+=pB1[r]; l_reg+=sacc;
    pw0=(u32x4){PKW(pB0,0),PKW(pB0,2),PKW(pB0,4),PKW(pB0,6)};pw1=(u32x4){PKW(pB0,8),PKW(pB0,10),PKW(pB0,12),PKW(pB0,14)};pw2=(u32x4){PKW(pB1,0),PKW(pB1,2),PKW(pB1,4),PKW(pB1,6)};pw3=(u32x4){PKW(pB1,8),PKW(pB1,10),PKW(pB1,12),PKW(pB1,14)};
    SBAR(); pv(o,vb0+sl_cur,PAF(0),PAF(1),PAF(2),PAF(3)); }
  #undef PKW
  #undef PAF
  #undef VFR
  #undef PIN
  #undef MX3
  #undef GAPA
  #undef GAPB
  #undef EX
  #undef VRD
  #undef KRD
  #undef STEP
  #undef ENDW
  {auto rr=__builtin_amdgcn_permlane32_swap(__float_as_uint(l_reg),__float_as_uint(l_reg),false,false);l_reg=__uint_as_float(rr[0])+__uint_as_float(rr[1]);}
  if(hi==0)wsf[32+r32]=l_reg;asm volatile("s_waitcnt lgkmcnt(0)":::"memory");
  float rli[16];
  #pragma unroll
  for(int r=0;r<16;++r)rli[r]=__builtin_amdgcn_rcpf(wsf[32+crow(r,hi)]);
  bf16*Ow=O+(rowbase+q0+wid*QBLK)*DMO+h*D;
  { bf16*stg=(bf16*)(shm+LDS_OST)+wid*2048;
    #pragma unroll
    for(int r=0;r<16;++r){const int orow=crow(r,hi);
      #pragma unroll
      for(int d0=0;d0<2;++d0)stg[orow*64+d0*32+r32]=__float2bfloat16(o[d0][r]*rli[r]);}
    asm volatile("s_waitcnt lgkmcnt(0)":::"memory");
    #pragma unroll
    for(int i=0;i<4;++i){const int row=i*8+(lane>>3),ch=lane&7; const u32x4 v=*(const u32x4*)(stg+row*64+ch*8); ATTN_STORE16(Ow+(long)row*DMO+ch*8,v);} }
  asm volatile("s_waitcnt lgkmcnt(0)\n\ts_barrier":::"memory");
  #undef DMA_K
  #undef DMA_V
  #undef CMASK
  #undef BIAS
  #undef START
  #undef RESC
  #undef ROT
}
constexpr int ATTN_LDS_BYTES=LDS_BYTES;
#undef SBAR
#undef WAIT_BAR
}
#define XB_TMO      128
#define XB_XCNT(j)  (256  + 64 * (j))
#define XB_XSUB(j)  (1280 + 64 * (j))
#define XB_XGEN(j)  (2304 + 64 * (j))
#define XB_TOP      3328
#define XB_TOPGEN   3392
#define XCD_BAR_WORDS 3456
#define XB_SPIN_CAP (1u << 18)

__device__ __forceinline__ unsigned xb_ld(unsigned* p)              { return __hip_atomic_load(p, __ATOMIC_RELAXED, __HIP_MEMORY_SCOPE_AGENT); }
__device__ __forceinline__ unsigned xb_add(unsigned* p, unsigned v) { return __hip_atomic_fetch_add(p, v, __ATOMIC_RELAXED, __HIP_MEMORY_SCOPE_AGENT); }
__device__ __forceinline__ unsigned xb_xcc_id() { return (unsigned)__builtin_amdgcn_s_getreg((3 << 11) | 20) & 0xFu; }
#define XB_SPIN(cond, bar) do { unsigned _sp = 0; while (cond) { __builtin_amdgcn_s_sleep(1); \
    if ((++_sp & 255u) == 0u) { if (xb_ld(&(bar)[XB_TMO])) break; if (_sp > XB_SPIN_CAP) { atomicAdd(&(bar)[XB_TMO], 1u); break; } } } } while (0)

struct XcdBarrier {
    unsigned* bar; unsigned x;
    volatile LAS unsigned* st;
};

__device__ __forceinline__ XcdBarrier xcd_barrier_post(unsigned* bar, volatile LAS unsigned* st) {
    XcdBarrier b; b.bar = bar; b.x = xb_xcc_id(); b.st = st;
    if (threadIdx.x == 0) (void)xb_add(&bar[XB_XCNT(b.x)], 1u);
    return b;
}
__device__ __forceinline__ void xcd_barrier_complete(unsigned* bar, unsigned x, unsigned& nloc, unsigned& nx) {
    const unsigned G = gridDim.x * gridDim.y * gridDim.z;
    unsigned sum, cnt, mine, sp = 0u;
    for (;;) {
        sum = 0u; cnt = 0u; mine = 0u;
#pragma unroll
        for (unsigned j = 0; j < 16; ++j) { const unsigned c = xb_ld(&bar[XB_XCNT(j)]); sum += c; cnt += (c > 0u) ? 1u : 0u; mine = (j == x) ? c : mine; }
        if (sum == G) break;
        __builtin_amdgcn_s_sleep(1);
        if ((++sp & 255u) == 0u) { if (xb_ld(&bar[XB_TMO])) break; if (sp > XB_SPIN_CAP) { atomicAdd(&bar[XB_TMO], 1u); break; } }
    }
    nloc = mine > 0u ? mine : 1u; nx = cnt > 0u ? cnt : 1u;
}

__device__ __forceinline__ void xcd_barrier(const XcdBarrier& b) {
    asm volatile("s_waitcnt vmcnt(0)" ::: "memory");
    __syncthreads();
    if (threadIdx.x == 0) {
        unsigned* bar = b.bar;
        __builtin_amdgcn_s_waitcnt(0);
        unsigned nloc = b.st[0], nx = b.st[1];
        if (nloc == 0u) { xcd_barrier_complete(bar, b.x, nloc, nx); b.st[0] = nloc; b.st[1] = nx; }
        const unsigned old = xb_add(&bar[XB_XSUB(b.x)], 1u);
        const unsigned gen = old / nloc;
        if (old + 1u == (gen + 1u) * nloc) {
            __builtin_amdgcn_fence(__ATOMIC_RELEASE, "agent");
            asm volatile("s_waitcnt vmcnt(0)" ::: "memory");
            const unsigned og = xb_add(&bar[XB_TOP], 1u);
            const unsigned tg = og / nx;
            if (og + 1u == (tg + 1u) * nx) xb_add(&bar[XB_TOPGEN], 1u);
            else XB_SPIN(xb_ld(&bar[XB_TOPGEN]) == tg, bar);
            __builtin_amdgcn_fence(__ATOMIC_ACQUIRE, "agent");
            xb_add(&bar[XB_XGEN(b.x)], 1u);
            asm volatile("s_waitcnt vmcnt(0)" ::: "memory");
        } else {
            XB_SPIN(xb_ld(&bar[XB_XGEN(b.x)]) == gen, bar);
            __builtin_amdgcn_fence(__ATOMIC_ACQUIRE, "agent");
            asm volatile("s_waitcnt vmcnt(0)" ::: "memory");
        }
    }
    __syncthreads();
}
struct Args { const float* in[21]; float* out; unsigned char* ws; int ph_lo, ph_hi; };
enum { I_X = 0, I_MEM, I_REL, I_MEMNORM, I_NORMF, I_NORMMIX, I_WIN, I_FBIAS, I_GW2, I_GB, I_CNORM, I_WOUT, I_NORMCROSS, I_WCQ, I_WCKV, I_WCO, I_NORMFFN, I_WUP, I_CONVW, I_CONVB, I_WDOWN };
#ifndef PROBE_PH
#define PROBE_PH -1
#endif
#ifndef PROBE_SUB
#define PROBE_SUB 0
#endif
constexpr int LDS_BARW = 149504;
constexpr size_t WS_QG = 938 * MiB, WS_KG = 962 * MiB, WS_END2 = 986 * MiB;
constexpr size_t WS_TOT = WS_DEC + 900 * 1024, WS_OFFS = WS_TOT + 8192, WS_NRM = WS_OFFS + 8192;
constexpr size_t WS_SS = 986 * MiB, SS_BYTES = 2 * MiB;
constexpr int PH_PER_LAYER = 12, N_PHASES = PH_PER_LAYER * DEPTH + 1;

constexpr int WT_IA = 32 * 200, WT_IB = 32 * 64, WT_IC = 32 * 16, WT_ID = 32 * 32, WT_IE = 8 * 64, WT_IF = 32 * 344, WT_IG = 86 * 64;
constexpr int WT_EARLY = WT_IA + WT_IB + WT_IC + WT_ID + WT_IE, WT_NIT = WT_EARLY + WT_IF + WT_IG;
#define WT_FIRST5(r_, ll) do { int q_ = (r_); \
        if (q_ < WT_IA) { wt_item<1>(ap->in[I_WIN] + (size_t)(ll) * D * PROJW, D, PROJW, Win, scr, q_, 200, 1.f, ap->in[I_NORMMIX] + (size_t)(ll) * D, lane); break; } q_ -= WT_IA; \
        if (q_ < WT_IB) { wt_item<0>(ap->in[I_WOUT] + (size_t)(ll) * D * D, D, D, Wout, scr, q_, 64, 1.f, nullptr, lane); break; } q_ -= WT_IB; \
        if (q_ < WT_IC) { wt_item<0>(ap->in[I_WCQ] + (size_t)(ll) * D * CW, D, CW, Wcq, scr, q_, 16, 0.08838834764831845f * LOG2E, ap->in[I_NORMCROSS] + (size_t)(ll) * D, lane); break; } q_ -= WT_IC; \
        if (q_ < WT_ID) { wt_item<0>(ap->in[I_WCKV] + (size_t)(ll) * D * 2 * CW, D, 2 * CW, Wckv, scr, q_, 32, 1.f, nullptr, lane); break; } q_ -= WT_ID; \
        wt_item<0>(ap->in[I_WCO] + (size_t)(ll) * CW * D, CW, D, Wco, scr, q_, 64, 1.f, nullptr, lane); } while (0)

__global__ void __launch_bounds__(NTHR, 2) fwd_mega(Args args) {
    extern __shared__ __attribute__((aligned(16))) unsigned char lds_raw[];
    LAS char* lds = (LAS char*)lds_raw;
    cg::grid_group grid = cg::this_grid();
    const int G0 = gridDim.x, bx0 = blockIdx.x;
    const int vcu0 = (G0 % 8 == 0) ? (bx0 % 8) * (G0 / 8) + bx0 / 8 : bx0;
    typedef const __attribute__((address_space(4))) Args* KArgs;
    KArgs ap = (KArgs)__builtin_amdgcn_kernarg_segment_ptr();
    const int ph_lo = args.ph_lo, ph_hi = args.ph_hi;
    if (threadIdx.x < 2) ((LAS unsigned*)(lds + LDS_BARW))[threadIdx.x] = 0u;
    __syncthreads();
    XcdBarrier bar = xcd_barrier_post((unsigned*)(args.ws + WS_CTL) + 4096, (volatile LAS unsigned*)(lds + LDS_BARW));
    int probe_done = 0, in_rep = 0;
    for (int ph = ph_lo; ph < ph_hi; ++ph) {
        const int tid = otid(), lane = tid & 63; const int wave = __builtin_amdgcn_readfirstlane(tid >> 6);
        int G = G0, bx = bx0, vcu = vcu0; asm volatile("" : "+s"(G), "+s"(bx), "+s"(vcu));
        asm volatile("" : "+s"(ap));
        const int gw = vcu * NWAVES + wave, NGW = G * NWAVES;
        unsigned char* ws = ap->ws;
        bf16* Win = (bf16*)(ws + WS_WIN); bf16* Wout = (bf16*)(ws + WS_WOUT); bf16* Wcq = (bf16*)(ws + WS_WCQ); bf16* Wckv = (bf16*)(ws + WS_WCKV);
        bf16* Wco = (bf16*)(ws + WS_WCO); bf16* Wup = (bf16*)(ws + WS_WUP); bf16* Wdown = (bf16*)(ws + WS_WDOWN);
        bf16* XN = (bf16*)(ws + WS_XN); bf16* OA = (bf16*)ap->out;     bf16* PROJ = (bf16*)(ws + WS_PROJ); bf16* QKVA = (bf16*)(ws + WS_QKVA); bf16* ACT = (bf16*)(ws + WS_ACT);
        bf16* QC = (bf16*)(ws + WS_QC); bf16* OC = (bf16*)(ws + WS_OC); bf16* MIXED = (bf16*)(ws + WS_MIXED); bf16* MEMN = (bf16*)(ws + WS_MEMN); bf16* KVC = (bf16*)(ws + WS_KVC);
        bf16* SC = (bf16*)(ws + WS_SC); float* DEC = (float*)(ws + WS_DEC); float* C2 = (float*)(ws + WS_C2); float* LSE = (float*)(ws + WS_LSE);
        float* GLb = (float*)(ws + WS_GL); float* GFb = (float*)(ws + WS_GF); float* VFb = (float*)(ws + WS_VF);
        unsigned long long* SSB = (unsigned long long*)(ws + WS_SS);
        bf16* QG = (bf16*)(ws + WS_QG); bf16* KG = (bf16*)(ws + WS_KG); float* TOTB = (float*)(ws + WS_TOT); float* OFFS = (float*)(ws + WS_OFFS); float* NRM = (float*)(ws + WS_NRM);
        const int l = ph / PH_PER_LAYER, k = (ph == N_PHASES - 1) ? 99 : ph % PH_PER_LAYER;
        switch (k) {
        case 0: {
            LAS float* scr = (LAS float*)(lds + wave * 16384);
            const float* wup = ap->in[I_WUP] + (size_t)l * D * 2 * DFF; const float* wdown = ap->in[I_WDOWN] + (size_t)l * DFF * D;
            for (int it = ((l > 0 && G == 256) ? WT_EARLY : 0) + gw; it < WT_NIT; it += NGW) {
                int r = it;
                if (r < WT_EARLY) { WT_FIRST5(r, l); continue; } r -= WT_EARLY;
                if (r < WT_IF) { wt_item<2>(wup, D, 2 * DFF, Wup, scr, r, 344, 1.f, ap->in[I_NORMFFN] + (size_t)l * D, lane); continue; } r -= WT_IF;
                wt_item<0>(wdown, DFF, D, Wdown, scr, r, 64, 1.f, nullptr, lane);
            }
            if (l == 0) {
                for (int m = gw; m < T; m += NGW) xconv_row(ap->in[I_X] + (size_t)m * D, XN + (size_t)m * D, SSB + m, lane);
                for (int m = gw; m < BATCH * MEMLEN; m += NGW) norm_row_bf16(ap->in[I_MEM] + (size_t)m * D, ap->in[I_MEMNORM], MEMN + (size_t)m * D, lane);
            }
        } break;
        case 1: {
            { pg8::Gemm g{XN, Win, T, PROJN, D}; pg8::StaticOrder S; S.init(T, PROJN, G, bx); pg8::EpiBf16 E{QKVA, QAP, PROJ, PROJP, QAP / 256, SSB + (size_t)(3 * l) * T};
              pg8::gemm_phase<pg8::EpiBf16, pg8::StaticOrder, true, true>((LAS unsigned char*)lds, g, S, E); }
            { pg8::Gemm g{MEMN, Wckv, BATCH * MEMLEN, 2 * CW, D}; pg8::StaticOrder S; S.init(BATCH * MEMLEN, 2 * CW, G, (bx + G - G / 2) % G); pg8::EpiBf16 E{KVC, 2 * CW, nullptr, 0, 0, nullptr};
              pg8::gemm_phase<pg8::EpiBf16, pg8::StaticOrder, true, true>((LAS unsigned char*)lds, g, S, E); }
        } break;
        case 2: {
            for (int c = vcu; c < T / 128; c += G) fscan_chunk(lds, c, PROJ, ap->in[I_FBIAS] + l * 8, C2, TOTB);
            if (!(in_rep && PROBE_SUB == 1)) for (int j_ = vcu; j_ < 2048; j_ += G) gla_unit<1>(lds, ((j_ >> 9) * 4 + (j_ & 3)) * 128 + ((j_ >> 2) & 127), PROJ,     ap->in[I_GW2] + (size_t)l * 16 * 384, ap->in[I_GB] + l * 384, SC, DEC, nullptr, nullptr, QG, KG);
            if (!(in_rep && PROBE_SUB == 2)) {
                DilRegs RG = {}; DilU cur = {}, nxt = {}; int it = 0;
#define DIL_MAKE(A, uu) do { const int p_ = (uu) / 1536, rem_ = (uu) - 1536 * p_, bc_ = rem_ / 12, h_ = rem_ - 12 * bc_, b_ = bc_ >> 5, cb_ = bc_ & 31;     \
                const int r_ = (p_ == 0) ? 1 : (p_ == 1 ? 4 : 16), nbk_ = 32 / r_, c_ = cb_ / nbk_, n_ = cb_ - nbk_ * c_; \
                const size_t qrow_ = (size_t)b_ * SEQ + c_ + (size_t)r_ * 256 * n_; const long krow_ = (long)b_ * SEQ + c_ + (long)r_ * (256 * n_ - 128); \
                (A).Qb = QKVA + qrow_ * QAP + O_QA + 64 * h_; (A).qstride = r_ * QAP; \
                (A).Kb = QKVA + krow_ * QAP + O_KA + 64 * h_; (A).kstride = r_ * QAP; (A).row_lo = (n_ == 0) ? 128 : 0; \
                (A).Ob = OA + (size_t)p_ * T * 768 + qrow_ * 768 + 64 * h_; (A).ostride = r_ * 768; \
                (A).lse = LSE + (size_t)p_ * T * 12 + qrow_ * 12 + h_; (A).lstride = r_ * 12; } while (0)
#define DIL_TBLP(uu) ((const LAS float*)(lds + DIL_TBLS) + (((uu) / 1536) * 12 + ((uu) % 1536) % 12) * 192)
                for (int e = tid; e < 36 * 192; e += NTHR) { const int tb_ = e / 192, st_ = e - 192 * tb_ - 32, p_ = tb_ / 12, h_ = tb_ - 12 * p_, r_ = (p_ == 0) ? 1 : (p_ == 1 ? 4 : 16); float tv = -INFINITY;
                    if (st_ >= 0 && st_ <= 128) { const int dist = st_ * r_; int bk;
                        if (dist < 16) bk = dist; else { bk = 16 + (int)(logf((float)dist * (1.f / 16.f)) / logf(128.f) * 16.f); bk = bk > 31 ? 31 : bk; }
                        tv = ap->in[I_REL][bk * 12 + h_] * LOG2E; }
                    ((LAS float*)(lds + DIL_TBLS))[e] = tv; }
                if (vcu < 4608) { DIL_MAKE(cur, vcu); DIL_GLOAD(cur, RG); }
                for (int u = vcu; u < 4608; u += G) {
                    const bool has_next = (u + G < 4608);
                    DIL_LWRITE(RG);
                    bf16x8 qf[4];
#pragma unroll
                    for (int d0 = 0; d0 < 4; ++d0) qf[d0] = RG.q[d0];
                    __syncthreads();
                    if (has_next) { DIL_MAKE(nxt, u + G); DIL_GLOAD(nxt, RG); }
                    dil_compute(lds, cur, DIL_TBLP(u), tid, qf);
                    asm volatile("s_waitcnt lgkmcnt(0)\n\ts_barrier" ::: "memory");
                    cur = nxt; ++it;
                }
#undef DIL_MAKE
#undef DIL_TBLP
            }
        } break;
        case 3: {
            if (vcu == G - 1 && tid < 32) { const int b_ = tid >> 3, h_ = tid & 7; float acc = 0.f;
                for (int cc = 0; cc < 64; ++cc) { OFFS[(b_ * 64 + cc) * 8 + h_] = acc; acc += TOTB[(b_ * 64 + cc) * 8 + h_]; } }
            {
                for (int it = gw; it < 2 * 4096; it += NGW) { const int isk = it >= 4096, tt = it & 4095, bh_ = tt >> 7, t64 = tt & 127;
                    const bf16* rp = PROJ + ((size_t)(bh_ >> 3) * SEQ + 64 * t64 + lane) * PROJP + (isk ? O_KB : O_QB) + 64 * (bh_ & 7);
                    float s2 = 0.f;
#pragma unroll
                    for (int c8 = 0; c8 < 8; ++c8) { const u32x4 v = *(const u32x4*)(rp + 8 * c8);
#pragma unroll
                        for (int q = 0; q < 4; ++q) { const float a0 = bflo(v[q]), a1 = bfhi(v[q]); s2 += a0 * a0 + a1 * a1; } }
#pragma unroll
                    for (int o = 1; o < 64; o <<= 1) s2 = fmaxf(s2, __shfl_xor(s2, o));
                    if (lane == 0) NRM[it] = sqrtf(s2); }
            }
            {
                if (tid < 288) for (int pb = vcu * 576; pb < 16 * 9216; pb += G * 576) {
                    unsigned* sp[2]; const float* dp[2]; float st[2][2]; bool ok[2];
#pragma unroll
                    for (int q = 0; q < 2; ++q) { const int pe = pb + tid + 288 * q; ok[q] = pe < 16 * 9216; const int pp = ok[q] ? pe : 0; const int bh = pp / 9216, vk = pp - 9216 * bh, k0 = 2 * (vk % 48);
                        sp[q] = (unsigned*)SC + (size_t)bh * 128 * 9216 + vk; dp[q] = DEC + (size_t)bh * 128 * 96 + k0; st[q][0] = 0.f; st[q][1] = 0.f; }
                    for (int n = 0; n < 128; n += 8) { unsigned tv[2][8]; float d0[2][8], d1[2][8];
#pragma unroll
                        for (int q = 0; q < 2; ++q)
#pragma unroll
                            for (int jj = 0; jj < 8; ++jj) { tv[q][jj] = sp[q][(size_t)(n + jj) * 9216]; d0[q][jj] = dp[q][(n + jj) * 96]; d1[q][jj] = dp[q][(n + jj) * 96 + 1]; }
#pragma unroll
                        for (int q = 0; q < 2; ++q) if (ok[q]) {
#pragma unroll
                            for (int jj = 0; jj < 8; ++jj) { sp[q][(size_t)(n + jj) * 9216] = pk2(st[q][0], st[q][1]);
                                st[q][0] = st[q][0] * d0[q][jj] + bflo(tv[q][jj]); st[q][1] = st[q][1] * d1[q][jj] + bfhi(tv[q][jj]); } } } }
            }
            {
                const int gt = vcu * NTHR + tid, NGT = G * NTHR;
                for (int e0 = gt; e0 < T * 96; e0 += 4 * NGT) {
                    float ls[4][3]; u32x4 ov[4][3]; int tt[4], cc[4]; bool ok[4];
#pragma unroll
                    for (int q = 0; q < 4; ++q) { const int e = e0 + q * NGT; ok[q] = e < T * 96; const int ee = ok[q] ? e : e0; const int t = ee / 96, rem = ee - 96 * t, h = rem >> 3, ch = rem & 7; tt[q] = t; cc[q] = 64 * h + 8 * ch;
#pragma unroll
                        for (int pp = 0; pp < 3; ++pp) { ls[q][pp] = LSE[(size_t)pp * T * 12 + (size_t)t * 12 + h]; ov[q][pp] = *(const u32x4*)(OA + (size_t)pp * T * 768 + (size_t)t * 768 + cc[q]); } }
#pragma unroll
                    for (int q = 0; q < 4; ++q) if (ok[q]) {
                        const float mx = fmaxf(fmaxf(ls[q][0], ls[q][1]), ls[q][2]);
                        float wsum = 0.f, acc[8];
#pragma unroll
                        for (int jj = 0; jj < 8; ++jj) acc[jj] = 0.f;
#pragma unroll
                        for (int pp = 0; pp < 3; ++pp) { const float wp = __builtin_amdgcn_exp2f(ls[q][pp] - mx); wsum += wp;
#pragma unroll
                            for (int x = 0; x < 4; ++x) { acc[2 * x] += wp * bflo(ov[q][pp][x]); acc[2 * x + 1] += wp * bfhi(ov[q][pp][x]); } }
                        const float inv = 1.f / wsum; u32x4 o;
#pragma unroll
                        for (int x = 0; x < 4; ++x) o[x] = pk2(acc[2 * x] * inv, acc[2 * x + 1] * inv);
                        *(u32x4*)(MIXED + (size_t)tt[q] * D + cc[q]) = o; } }
            }
        } break;
        case 4: {
            if (!(in_rep && PROBE_SUB == 1)) for (int j_ = vcu; j_ < 2048; j_ += G) gla_unit<3>(lds, ((j_ >> 9) * 4 + (j_ & 3)) * 128 + ((j_ >> 2) & 127), PROJ, ap->in[I_GW2] + (size_t)l * 16 * 384, ap->in[I_GB] + l * 384, SC, DEC, ap->in[I_CNORM] + l * 192, MIXED, QG, KG);
            if (!(in_rep && PROBE_SUB == 2)) {
                static_assert(attn_body::ATTN_LDS_BYTES <= LDS_BARW, "attention LDS");
                for (int i = 0; i < 4; ++i) {
                    int bh, qb;
                    if (G == 256) { const int s = vcu & 7; bh = vcu >> 3; qb = (i == 0) ? s : (i == 1) ? 15 - s : (i == 2) ? 16 + s : 31 - s; }
                    else { const int u = vcu + i * G; if (u >= 1024) break; bh = u >> 5; qb = u & 31; }
                    int ts = 0;
                    { const int NTf = 4 * (qb + 1); const float* cg = C2 + (size_t)bh * SEQ; const float* og = OFFS + (size_t)(bh >> 3) * 64 * 8 + (bh & 7);
                      const float* qn = NRM + bh * 128 + 4 * qb; const float* kn = NRM + 4096 + bh * 128;
                      const float Qn = fmaxf(fmaxf(qn[0], qn[1]), fmaxf(qn[2], qn[3])) * 1.01f;
                      const int t0_ = lane, t1_ = lane + 64;
                      const float k0_ = (t0_ < NTf) ? kn[t0_] : 0.f, k1_ = (t1_ < NTf) ? kn[t1_] : 0.f;
                      float kmax = fmaxf(k0_, k1_);
#pragma unroll
                      for (int o = 1; o < 64; o <<= 1) kmax = fmaxf(kmax, __shfl_xor(kmax, o));
                      kmax *= 1.01f;
                      const int q0_ = 256 * qb; const float Cq = cg[q0_] + og[(q0_ >> 7) * 8];
                      const float thr = -Qn * kmax - 150.f;
                      bool keep0 = true, keep1 = true;
                      if (t0_ < NTf) { const int e = 64 * t0_ + 63; keep0 = !(Qn * k0_ * 1.01f + (Cq - (cg[e] + og[(e >> 7) * 8])) < thr); }
                      if (t1_ < NTf) { const int e = 64 * t1_ + 63; keep1 = !(Qn * k1_ * 1.01f + (Cq - (cg[e] + og[(e >> 7) * 8])) < thr); }
                      const unsigned long long b0 = __ballot(keep0), b1 = __ballot(keep1);
                      const int first = b0 ? __builtin_ctzll(b0) : 64 + (b1 ? __builtin_ctzll(b1) : 0);
                      ts = first & ~1; if (ts > NTf - 4) ts = NTf - 4; if (ts < 0) ts = 0;
                      ts = __builtin_amdgcn_readfirstlane(ts); }
                    attn_body::attn_unit<40>(bh >> 3, bh & 7, qb, (const attn_body::bf16*)(PROJ + O_QB), (const attn_body::bf16*)(PROJ + O_KB), (const attn_body::bf16*)(PROJ + O_VB),
                                            (attn_body::bf16*)(MIXED + 768), C2 + (size_t)bh * SEQ, OFFS + (size_t)(bh >> 3) * 64 * 8 + (bh & 7), ts, (char*)lds_raw);
                }
            }
        } break;
        case 5: case 8: case 11: {
            pg8::Gemm g; if (k == 5) g = pg8::Gemm{MIXED, Wout, T, D, D}; else if (k == 8) g = pg8::Gemm{OC, Wco, T, D, CW}; else g = pg8::Gemm{ACT, Wdown, T, D, DFF};
            unsigned long long* ssn = SSB + (size_t)(k == 5 ? 3 * l + 1 : (k == 8 ? 3 * l + 2 : 3 * l + 3)) * T;
            pg8::StaticOrder S; S.init(T, D, G, bx); pg8::EpiRes E{XN, D, (k == 11 && l == DEPTH - 1) ? nullptr : ssn};
            pg8::gemm_phase<pg8::EpiRes, pg8::StaticOrder, true, true>((LAS unsigned char*)lds, g, S, E);
        } break;
        case 6: {
            pg8::Gemm g{XN, Wcq, T, CW, D}; pg8::StaticOrder S; S.init(T, CW, G, bx); pg8::EpiBf16 E{QC, CW, nullptr, 0, 0, SSB + (size_t)(3 * l + 1) * T};
            pg8::gemm_phase<pg8::EpiBf16, pg8::StaticOrder, true, true>((LAS unsigned char*)lds, g, S, E);
        } break;
        case 7: {
            for (int u = vcu; u < 512; u += G) { const int b = u >> 7, qb = (u >> 2) & 31, h = u & 3;     const size_t qrow = (size_t)b * SEQ + 256 * qb;
                AttnU a;
                a.Qb = QC + qrow * CW + 128 * h; a.qstride = CW;
                a.Kb = KVC + (size_t)b * MEMLEN * 2 * CW + 128 * h; a.Vb = a.Kb + CW; a.kstride = 2 * CW;
                a.Ob = OC + qrow * CW + 128 * h; a.ostride = CW;
                a.NT = 4; a.t_begin = 0; a.cq = nullptr; a.ck = nullptr; a.q0 = 0; a.lse = nullptr; a.lstride = 0;
                attn_unit<128, 0>(lds, a, nullptr); }
        } break;
        case 9: {
            pg8::Gemm g{XN, Wup, T, 2 * DFF, D}; pg8::StaticOrder S; S.init(T, 2 * DFF, G, bx);
            pg8::EpiConv E{ACT, ap->in[I_CONVW] + (size_t)l * 3 * DFF, ap->in[I_CONVB] + (size_t)l * DFF, GLb, GFb, VFb, SSB + (size_t)(3 * l + 2) * T};
            pg8::gemm_phase<pg8::EpiConv, pg8::StaticOrder, true, true>((LAS unsigned char*)lds, g, S, E);
            if (l + 1 < DEPTH && G == 256 && bx >= 128) {
                LAS float* scr = (LAS float*)(lds + wave * 16384);
                for (int it = (bx - 128) * NWAVES + wave; it < WT_EARLY; it += 128 * NWAVES) WT_FIRST5(it, l + 1);
            }
        } break;
        case 10: {
            const float* cw = ap->in[I_CONVW] + (size_t)l * 3 * DFF; const float* cb = ap->in[I_CONVB] + (size_t)l * DFF;
            const int gt = vcu * NTHR + tid, NGT = G * NTHR;
            for (int e = gt; e < 512 * 1376; e += NGT) { const int sl = e / 1376, c4 = (e - 1376 * sl) * 4;
                f32x4 gm2 = (f32x4){0.f, 0.f, 0.f, 0.f}, gm1 = gm2;
                if (sl % 128 != 0) { gm2 = *(const f32x4*)(GLb + (size_t)((sl - 1) * 2) * DFF + c4); gm1 = *(const f32x4*)(GLb + (size_t)((sl - 1) * 2 + 1) * DFF + c4); }
                const f32x4 g0 = *(const f32x4*)(GFb + (size_t)(sl * 2) * DFF + c4), g1 = *(const f32x4*)(GFb + (size_t)(sl * 2 + 1) * DFF + c4);
                const f32x4 v0 = *(const f32x4*)(VFb + (size_t)(sl * 2) * DFF + c4), v1 = *(const f32x4*)(VFb + (size_t)(sl * 2 + 1) * DFF + c4);
                const f32x4 w0 = *(const f32x4*)(cw + c4), w1 = *(const f32x4*)(cw + DFF + c4), w2 = *(const f32x4*)(cw + 2 * DFF + c4), b4 = *(const f32x4*)(cb + c4);
                const f32x4 a0 = b4 + w0 * gm2 + w1 * gm1 + w2 * g0, a1 = b4 + w0 * gm1 + w1 * g0 + w2 * g1;
                float y0[4], y1[4];
#pragma unroll
                for (int q = 0; q < 4; ++q) { y0[q] = a0[q] / (1.f + __expf(-a0[q])) * v0[q]; y1[q] = a1[q] / (1.f + __expf(-a1[q])) * v1[q]; }
                u32x2 o0, o1; o0.x = pk2(y0[0], y0[1]); o0.y = pk2(y0[2], y0[3]); o1.x = pk2(y1[0], y1[1]); o1.y = pk2(y1[2], y1[3]);
                *(u32x2*)(ACT + (size_t)(64 * sl) * DFF + c4) = o0; *(u32x2*)(ACT + (size_t)(64 * sl + 1) * DFF + c4) = o1; }
        } break;
        default: {
            for (int m = gw; m < T; m += NGW) norm_row_out(XN + (size_t)m * D, ap->in[I_NORMF], ap->out + (size_t)m * D, lane);
        } break;
        }
        if (ph == PROBE_PH && !probe_done) { probe_done = 1; in_rep = 1; xcd_barrier(bar); --ph; continue; }
        in_rep = 0;
        if (ph + 1 < ph_hi) { if (ph == ph_lo) grid.sync(); else xcd_barrier(bar); }
    }
}

#ifndef N_LAUNCH_MODE
#define N_LAUNCH_MODE 1
#endif
extern "C" void kernel_launch(void* const* d_in, const int* in_sizes, int n_in, void* d_out, int out_size, void* d_ws, size_t ws_size, hipStream_t stream) {
    static int grid = 0;
    if (grid == 0) {
        if (n_in != 21 || out_size != T * D || ws_size < WS_SS + SS_BYTES) { fprintf(stderr, "kernel_launch: unexpected problem (n_in %d out %d ws %zu)\n", n_in, out_size, ws_size); grid = -1; return; }
        int dev = 0, cus = 0, per_cu = 0;
        hipGetDevice(&dev); hipDeviceGetAttribute(&cus, hipDeviceAttributeMultiprocessorCount, dev);
        if (hipFuncSetAttribute((const void*)fwd_mega, hipFuncAttributeMaxDynamicSharedMemorySize, LDS_BYTES) != hipSuccess) { fprintf(stderr, "kernel_launch: hipFuncSetAttribute failed\n"); grid = -1; return; }
        hipOccupancyMaxActiveBlocksPerMultiprocessor(&per_cu, (const void*)fwd_mega, NTHR, LDS_BYTES);
        (void)hipGetLastError();
        if (per_cu < 1) { fprintf(stderr, "kernel_launch: occupancy query says %d blocks per CU\n", per_cu); per_cu = 1; }
        grid = cus;
    }
    if (grid < 0) return;
    if (hipMemsetAsync((char*)d_ws + WS_CTL, 0, 1u << 20, stream) != hipSuccess) { fprintf(stderr, "kernel_launch: memset failed\n"); return; }
    if (hipMemsetAsync((char*)d_ws + WS_SS, 0, SS_BYTES, stream) != hipSuccess) { fprintf(stderr, "kernel_launch: memset failed\n"); return; }
    Args a{};
    for (int i = 0; i < 21; ++i) a.in[i] = (const float*)d_in[i];
    a.out = (float*)d_out; a.ws = (unsigned char*)d_ws;
#if N_LAUNCH_MODE == 1
    a.ph_lo = 0; a.ph_hi = N_PHASES;
    void* kargs[] = {&a};
    hipError_t e = hipLaunchCooperativeKernel((const void*)fwd_mega, dim3(grid), dim3(NTHR), kargs, LDS_BYTES, stream);
    if (e != hipSuccess) fprintf(stderr, "kernel_launch: cooperative launch failed: %s (grid %d)\n", hipGetErrorString(e), grid);
#else
    for (int ph = 0; ph < N_PHASES; ++ph) { a.ph_lo = ph; a.ph_hi = ph + 1; hipLaunchKernelGGL(fwd_mega, dim3(grid), dim3(NTHR), LDS_BYTES, stream, a); }
#endif
}
```

```cpp
#include <hip/hip_runtime.h>
#include <hip/hip_cooperative_groups.h>
#include <cstdio>
#include <cstdint>
#include <cmath>
namespace cg = cooperative_groups;
__device__ __forceinline__ int otid() { int t = threadIdx.x; asm volatile("" : "+v"(t)); return t; }
namespace pg8 {
#define PG8_LAS __attribute__((address_space(3)))
typedef unsigned short bf16_t;
typedef short bf16x8 __attribute__((ext_vector_type(8)));
typedef float f32x4 __attribute__((ext_vector_type(4)));
typedef unsigned u32x4 __attribute__((ext_vector_type(4)));
constexpr int BM = 256, BK = 64, HALF = 128, HTB = HALF * BK * 2  , STAGE_BYTES = 8 * HTB, NXCD = 8, WGM = 4;

__host__ __device__ __forceinline__ int lds_byte(int r, int c) { const int st = (r >> 4) * 2 + (c >> 5), rr = r & 15, cc = c & 31, ob = rr * 64 + cc * 2; return st * 1024 + (ob ^ (((ob >> 9) & 1) << 5)); }
__host__ __device__ __forceinline__ void stage_rc(int b, int& R, int& C) { const int st = b / 1024, sb = b % 1024, swz = sb ^ (((sb >> 9) & 1) << 5); R = (st >> 1) * 16 + swz / 64; C = (st & 1) * 32 + (swz % 64) / 2; }
__host__ __device__ __forceinline__ int perm32(int rho) { const int n = rho >> 4, i = rho & 15; return 8 * (i >> 2) + 4 * n + (i & 3); }

struct Unit { int pm, pn; };
struct Gemm { const bf16_t* A; const bf16_t* Bt; int M, N, K; };

struct StaticOrder {
    int nM, nN, nwg, G, c;
    __host__ __device__ void init(int M, int N, int G_, int c_) { nM = M / BM; nN = N / BM; nwg = nM * nN; G = G_; c = c_; }
    __host__ __device__ bool next(int i, Unit& u) const {
        const long L = (long)i * G + c; if (L >= nwg) return false;
        int wgid = (int)L; { const int q = nwg / NXCD, r = nwg % NXCD, xcd = wgid % NXCD, off = wgid / NXCD; wgid = (xcd < r ? xcd * (q + 1) : r * (q + 1) + (xcd - r) * q) + off; }
        const int nig = WGM * nN, gid = wgid / nig, fm = gid * WGM, gsz = (nM - fm) < WGM ? (nM - fm) : WGM;
        u.pm = fm + ((wgid % nig) % gsz); u.pn = (wgid % nig) / gsz; return true;
    }
    __device__ __forceinline__ void a_ready(const Unit&) const {}
    __device__ __forceinline__ void done(const Unit&) const {}
};

__device__ __forceinline__ unsigned cvt_pk_bf16(float lo, float hi) { unsigned r; asm volatile("v_cvt_pk_bf16_f32 %0, %1, %2" : "=v"(r) : "v"(lo), "v"(hi)); return r; }
typedef float f32x2 __attribute__((ext_vector_type(2)));
struct EpiBf16 {
    static constexpr bool PERM = true, AFTER_DRAIN = false;
    bf16_t* O; int ldc; bf16_t* O2; int ldc2, split;
    const unsigned long long* ss;
    __device__ __forceinline__ void operator()(const f32x4 (&acc)[2][2][4][2], const Unit& u, int wr, int wc, int fr, int fq) const {
        const int row0 = u.pm * BM + wr * 64 + fr; const bool second = split > 0 && u.pn >= split; const int col0 = (second ? u.pn - split : u.pn) * BM + wc * 32 + 8 * fq;
        bf16_t* const Ob = second ? O2 : O; const int ld = second ? ldc2 : ldc;
#pragma unroll
        for (int ai = 0; ai < 2; ++ai)
#pragma unroll
            for (int m = 0; m < 4; ++m) { bf16_t* rowp = Ob + (size_t)(row0 + ai * HALF + m * 16) * ld + col0;
                float rs = 1.f; if (ss) rs = 1.f / sqrtf((float)ss[row0 + ai * HALF + m * 16] * (1.f / (2048.f * 262144.f)) + 1e-6f);
#pragma unroll
                for (int bj = 0; bj < 2; ++bj) { const f32x4 v0 = acc[ai][bj][m][0] * rs, v1 = acc[ai][bj][m][1] * rs;
                    u32x4 w; w.x = cvt_pk_bf16(v0[0], v0[1]); w.y = cvt_pk_bf16(v0[2], v0[3]); w.z = cvt_pk_bf16(v1[0], v1[1]); w.w = cvt_pk_bf16(v1[2], v1[3]);
                    *(u32x4*)(rowp + bj * HALF) = w; } }
    }
};
struct EpiRes {
    static constexpr bool PERM = true, AFTER_DRAIN = false;
    bf16_t* x; int ldc; unsigned long long* ss;
    __device__ __forceinline__ void operator()(const f32x4 (&acc)[2][2][4][2], const Unit& u, int wr, int wc, int fr, int fq) const {
        const int col0 = u.pn * BM + wc * 32 + 8 * fq;
#pragma unroll
        for (int ai = 0; ai < 2; ++ai)
#pragma unroll
            for (int m = 0; m < 4; ++m) { const int row = u.pm * BM + ai * HALF + wr * 64 + m * 16 + fr; bf16_t* xp = x + (size_t)row * ldc + col0;
                u32x4 bv[2];
#pragma unroll
                for (int bj = 0; bj < 2; ++bj) bv[bj] = *(const u32x4*)(xp + bj * HALF);
                float sq = 0.f;
#pragma unroll
                for (int bj = 0; bj < 2; ++bj) { u32x4 w;
#pragma unroll
                    for (int n = 0; n < 2; ++n) { const f32x4 a = acc[ai][bj][m][n]; const unsigned b0 = bv[bj][2 * n], b1 = bv[bj][2 * n + 1];
                        const float o0 = __builtin_bit_cast(float, b0 << 16) + a[0], o1 = __builtin_bit_cast(float, b0 & 0xffff0000u) + a[1];
                        const float o2 = __builtin_bit_cast(float, b1 << 16) + a[2], o3 = __builtin_bit_cast(float, b1 & 0xffff0000u) + a[3];
                        sq += (o0 * o0 + o1 * o1) + (o2 * o2 + o3 * o3);
                        w[2 * n] = cvt_pk_bf16(o0, o1); w[2 * n + 1] = cvt_pk_bf16(o2, o3); }
                    *(u32x4*)(xp + bj * HALF) = w; }
                if (ss) { sq += __shfl_xor(sq, 16); sq += __shfl_xor(sq, 32); if (fq == 0) __hip_atomic_fetch_add(ss + row, (unsigned long long)(sq * 262144.f + 0.5f), __ATOMIC_RELAXED, __HIP_MEMORY_SCOPE_AGENT); } }
    }
};
struct EpiConv {
    static constexpr bool PERM = false, AFTER_DRAIN = false;
    bf16_t* ACT; const float* cw; const float* cb; float* GL; float* GF; float* VF; const unsigned long long* ss;
    __device__ __forceinline__ void operator()(const f32x4 (&acc)[2][2][4][2], const Unit& u, int wr, int wc, int fr, int fq) const {
        constexpr int FF = 5504;
        const int lane = otid() & 63;
        const int src1 = (lane & 48) | ((fr + 15) & 15), src2 = (lane & 48) | ((fr + 14) & 15);
        float rs[2][4];
#pragma unroll
        for (int ai = 0; ai < 2; ++ai)
#pragma unroll
            for (int m = 0; m < 4; ++m) rs[ai][m] = 1.f / sqrtf((float)ss[u.pm * BM + ai * HALF + wr * 64 + m * 16 + fr] * (1.f / (2048.f * 262144.f)) + 1e-6f);
#pragma unroll
        for (int n = 0; n < 2; ++n) {
            const int cbase = 128 * u.pn + 32 * wc + 16 * n + 4 * fq;
            const f32x4 w0 = *(const f32x4*)(cw + cbase), w1 = *(const f32x4*)(cw + FF + cbase), w2 = *(const f32x4*)(cw + 2 * FF + cbase), b4 = *(const f32x4*)(cb + cbase);
#pragma unroll
            for (int ai = 0; ai < 2; ++ai) {
                const int slab = u.pm * 4 + 2 * ai + wr;
                f32x4 r1p = (f32x4){0.f, 0.f, 0.f, 0.f}, r2p = (f32x4){0.f, 0.f, 0.f, 0.f};
#pragma unroll
                for (int m = 0; m < 4; ++m) {
                    const f32x4 g = acc[ai][1][m][n] * rs[ai][m], v = acc[ai][0][m][n] * rs[ai][m];
                    f32x4 r1, r2, a;
#pragma unroll
                    for (int e = 0; e < 4; ++e) { r1[e] = __shfl(g[e], src1); r2[e] = __shfl(g[e], src2); }
#pragma unroll
                    for (int e = 0; e < 4; ++e) {
                        const float p1 = fr >= 1 ? r1[e] : r1p[e], p2 = fr >= 2 ? r2[e] : r2p[e];
                        const float gg = b4[e] + w0[e] * p2 + w1[e] * p1 + w2[e] * g[e];
                        a[e] = gg * __builtin_amdgcn_rcpf(1.f + __expf(-gg)) * v[e];
                    }
                    r1p = r1; r2p = r2;
                    const size_t row = (size_t)(u.pm * BM + ai * HALF + wr * 64 + m * 16 + fr);
                    if (m == 0 && fr < 2) {
                        *(f32x4*)(GF + (size_t)(slab * 2 + fr) * FF + cbase) = g; *(f32x4*)(VF + (size_t)(slab * 2 + fr) * FF + cbase) = v;
                    } else {
                        typedef unsigned u32x2v __attribute__((ext_vector_type(2)));
                        u32x2v w; w.x = cvt_pk_bf16(a[0], a[1]); w.y = cvt_pk_bf16(a[2], a[3]);
                        *(u32x2v*)(ACT + row * FF + cbase) = w;
                    }
                    if (m == 3 && fr >= 14) *(f32x4*)(GL + (size_t)(slab * 2 + fr - 14) * FF + cbase) = g;
                }
            }
        }
    }
};
template <class Epi, class Sched, bool ALIGN_EPI = false, bool SP2 = false>
__device__ __forceinline__ void gemm_phase(PG8_LAS unsigned char* lds, const Gemm g, const Sched& S, const Epi& E) {
    const int tid = otid(), wid = __builtin_amdgcn_readfirstlane(tid >> 6), lane = tid & 63, wr = wid >> 2, wc = wid & 3, fr = lane & 15, fq = lane >> 4;
    const int K = g.K, nt = K / BK;
    unsigned voffA[2], voffB[2];
#pragma unroll
    for (int i = 0; i < 2; ++i) { int R, C; stage_rc(tid * 16 + i * 8192, R, C); const int Rb = Epi::PERM ? ((R & ~31) + perm32(R & 31)) : R;
        voffA[i] = (unsigned)(R * K + C) * 2u; voffB[i] = (unsigned)(Rb * K + C) * 2u; }
    const size_t kstep = (size_t)(BK * 2);
    const size_t hstep = (size_t)HALF * K * 2;
    const size_t tstep = 2 * hstep;
    const unsigned ldsw = (unsigned)wid * 1024u;
    const int aoff = lds_byte(wr * 64 + fr, fq * 8), boff = lds_byte(wc * 32 + fr, fq * 8);
#define PG8_SA(b, h) (((b) * 2 + (h)) * HTB)
#define PG8_SB(b, h) ((4 + (b) * 2 + (h)) * HTB)
#define PG8_STAGE(bufoff, gbase, voff) do { _Pragma("unroll") for (int _i = 0; _i < 2; ++_i) \
        __builtin_amdgcn_global_load_lds((const unsigned*)((const char*)(gbase) + (voff)[_i]), (PG8_LAS unsigned*)(lds + (bufoff) + ldsw + _i * 8192), 16, 0, 0); } while (0)
#define PG8_LDA(dst, b, h) do { _Pragma("unroll") for (int m = 0; m < 4; ++m) _Pragma("unroll") for (int k = 0; k < 2; ++k) dst[m][k] = *(const PG8_LAS bf16x8*)(lds + PG8_SA(b, h) + aoff + m * 2048 + k * 1024); } while (0)
#define PG8_LDB(dst, b, h) do { _Pragma("unroll") for (int n = 0; n < 2; ++n) _Pragma("unroll") for (int k = 0; k < 2; ++k) dst[n][k] = *(const PG8_LAS bf16x8*)(lds + PG8_SB(b, h) + boff + n * 2048 + k * 1024); } while (0)
#define PG8_MMA(ai, bj, At, Bt) do { __builtin_amdgcn_s_setprio(1); _Pragma("unroll") for (int m = 0; m < 4; ++m) _Pragma("unroll") for (int n = 0; n < 2; ++n) _Pragma("unroll") for (int k = 0; k < 2; ++k) \
        acc[ai][bj][m][n] = __builtin_amdgcn_mfma_f32_16x16x32_bf16(Bt[n][k], At[m][k], acc[ai][bj][m][n], 0, 0, 0); __builtin_amdgcn_s_setprio(0); } while (0)
#define PG8_WAIT_V(n) asm volatile("s_waitcnt vmcnt(" #n ")" ::: "memory")
#define PG8_WAIT_L(n) asm volatile("s_waitcnt lgkmcnt(" #n ")" ::: "memory")
#define PG8_BAR __builtin_amdgcn_s_barrier()
#define PG8_SCHED __builtin_amdgcn_sched_barrier(0)
    Unit cur, nxt; int ui = 0;
    if (!S.next(0, cur)) return;
    f32x4 acc[2][2][4][2];
#pragma unroll
    for (int a = 0; a < 2; ++a)
#pragma unroll
        for (int b = 0; b < 2; ++b)
#pragma unroll
            for (int m = 0; m < 4; ++m)
#pragma unroll
                for (int n = 0; n < 2; ++n) acc[a][b][m][n] = (f32x4){0.f, 0.f, 0.f, 0.f};
    bf16x8 At[4][2], B0[2][2], B1[2][2];
    const char* cA = (const char*)g.A + (size_t)cur.pm * tstep; const char* cB = (const char*)g.Bt + (size_t)cur.pn * tstep;
    S.a_ready(cur);
    if constexpr (SP2) {
        PG8_STAGE(PG8_SB(0, 0), cB, voffB); PG8_STAGE(PG8_SB(0, 1), cB + hstep, voffB); PG8_STAGE(PG8_SA(0, 0), cA, voffA); PG8_STAGE(PG8_SA(0, 1), cA + hstep, voffA);
        if (wr == 1) PG8_BAR;
        PG8_WAIT_V(2); PG8_BAR;
        PG8_STAGE(PG8_SB(1, 0), cB + kstep, voffB); PG8_STAGE(PG8_SA(1, 0), cA + kstep, voffA); PG8_STAGE(PG8_SB(1, 1), cB + hstep + kstep, voffB);
        PG8_WAIT_V(6); PG8_BAR;
    } else {
        PG8_STAGE(PG8_SB(0, 0), cB, voffB); PG8_STAGE(PG8_SA(0, 0), cA, voffA); PG8_STAGE(PG8_SB(0, 1), cB + hstep, voffB); PG8_STAGE(PG8_SA(0, 1), cA + hstep, voffA);
        if (wr == 1) PG8_BAR;
        PG8_WAIT_V(4); PG8_BAR;
        PG8_STAGE(PG8_SB(1, 0), cB + kstep, voffB); PG8_STAGE(PG8_SA(1, 0), cA + kstep, voffA); PG8_STAGE(PG8_SB(1, 1), cB + hstep + kstep, voffB);
        PG8_WAIT_V(6); PG8_BAR;
    }
    for (;;) {
        const bool has_next = S.next(ui + 1, nxt);
        const char* nA = has_next ? (const char*)g.A + (size_t)nxt.pm * tstep : cA; const char* nB = has_next ? (const char*)g.Bt + (size_t)nxt.pn * tstep : cB;
        for (int t = 0; t < nt; t += 2) {
            const bool last = (t == nt - 2);
            const char* a1 = cA + (size_t)(t + 1) * kstep;
            const char* a2 = last ? nA : cA + (size_t)(t + 2) * kstep; const char* b2 = last ? nB : cB + (size_t)(t + 2) * kstep;
            const char* a3 = a2 + kstep; const char* b3 = b2 + kstep;
            if (last && has_next) S.a_ready(nxt);
            if constexpr (SP2) {
            PG8_LDB(B0, 0, 0); PG8_LDB(B1, 0, 1); PG8_SCHED; PG8_LDA(At, 0, 0); PG8_STAGE(PG8_SA(1, 1), a1 + hstep, voffA);
            PG8_WAIT_V(8); PG8_WAIT_L(0); PG8_BAR; PG8_MMA(0, 0, At, B0); PG8_MMA(0, 1, At, B1); PG8_BAR; PG8_SCHED;
            PG8_LDA(At, 0, 1); PG8_STAGE(PG8_SB(0, 0), b2, voffB); PG8_STAGE(PG8_SB(0, 1), b2 + hstep, voffB); PG8_STAGE(PG8_SA(0, 0), a2, voffA);
            PG8_WAIT_V(8); PG8_WAIT_L(0); PG8_BAR; PG8_MMA(1, 0, At, B0); PG8_MMA(1, 1, At, B1); PG8_BAR; PG8_SCHED;
            PG8_LDB(B0, 1, 0); PG8_LDB(B1, 1, 1); PG8_SCHED; PG8_LDA(At, 1, 0); PG8_STAGE(PG8_SA(0, 1), a2 + hstep, voffA);
            PG8_WAIT_V(8); PG8_WAIT_L(0); PG8_BAR; PG8_MMA(0, 0, At, B0); PG8_MMA(0, 1, At, B1); PG8_BAR; PG8_SCHED;
            PG8_LDA(At, 1, 1); PG8_STAGE(PG8_SB(1, 0), b3, voffB); PG8_STAGE(PG8_SB(1, 1), b3 + hstep, voffB); PG8_STAGE(PG8_SA(1, 0), a3, voffA);
            PG8_WAIT_V(8); PG8_WAIT_L(0); PG8_BAR; PG8_MMA(1, 0, At, B0); PG8_MMA(1, 1, At, B1); PG8_BAR; PG8_SCHED;
            } else {
            PG8_LDB(B0, 0, 0); PG8_SCHED; PG8_LDA(At, 0, 0); PG8_STAGE(PG8_SA(1, 1), a1 + hstep, voffA);
            PG8_WAIT_L(8); PG8_BAR; PG8_WAIT_L(0); PG8_MMA(0, 0, At, B0); PG8_BAR; PG8_SCHED;
            PG8_LDB(B1, 0, 1); PG8_STAGE(PG8_SB(0, 0), b2, voffB);
            PG8_BAR; PG8_WAIT_L(0); PG8_MMA(0, 1, At, B1); PG8_BAR;
            PG8_LDA(At, 0, 1); PG8_STAGE(PG8_SA(0, 0), a2, voffA);
            PG8_BAR; PG8_WAIT_L(0); PG8_MMA(1, 0, At, B0); PG8_BAR; PG8_SCHED;
            PG8_STAGE(PG8_SB(0, 1), b2 + hstep, voffB);
            PG8_WAIT_V(6); PG8_BAR; PG8_MMA(1, 1, At, B1); PG8_BAR;
            PG8_LDB(B0, 1, 0); PG8_SCHED; PG8_LDA(At, 1, 0); PG8_STAGE(PG8_SA(0, 1), a2 + hstep, voffA);
            PG8_WAIT_L(8); PG8_BAR; PG8_WAIT_L(0); PG8_MMA(0, 0, At, B0); PG8_BAR; PG8_SCHED;
            PG8_LDB(B1, 1, 1); PG8_STAGE(PG8_SB(1, 0), b3, voffB);
            PG8_BAR; PG8_WAIT_L(0); PG8_MMA(0, 1, At, B1); PG8_BAR;
            PG8_LDA(At, 1, 1); PG8_STAGE(PG8_SA(1, 0), a3, voffA);
            PG8_BAR; PG8_WAIT_L(0); PG8_MMA(1, 0, At, B0); PG8_BAR; PG8_SCHED;
            PG8_STAGE(PG8_SB(1, 1), b3 + hstep, voffB);
            PG8_WAIT_V(6); PG8_BAR; PG8_MMA(1, 1, At, B1); PG8_BAR;
            }
        }
        if constexpr (ALIGN_EPI) { if (wr == 0) PG8_BAR; }
        if constexpr (!Epi::AFTER_DRAIN) { E(acc, cur, wr, wc, fr, fq); S.done(cur); }
        if (!has_next) break;
#pragma unroll
        for (int a = 0; a < 2; ++a)
#pragma unroll
            for (int b = 0; b < 2; ++b)
#pragma unroll
                for (int m = 0; m < 4; ++m)
#pragma unroll
                    for (int n = 0; n < 2; ++n) acc[a][b][m][n] = (f32x4){0.f, 0.f, 0.f, 0.f};
        cur = nxt; cA = nA; cB = nB; ++ui;
        if constexpr (ALIGN_EPI) { if (wr == 1) PG8_BAR; }
    }
    PG8_WAIT_V(0);
    if constexpr (!ALIGN_EPI) { if (wr == 0) PG8_BAR; }
    PG8_BAR;
    if constexpr (Epi::AFTER_DRAIN) { E.fused(acc, cur, wr, wc, fr, fq, lds, wid, lane); S.done(cur); }
#undef PG8_SA
#undef PG8_SB
#undef PG8_STAGE
#undef PG8_LDA
#undef PG8_LDB
#undef PG8_MMA
#undef PG8_WAIT_V
#undef PG8_WAIT_L
#undef PG8_BAR
#undef PG8_SCHED
}
}
#define DI __device__ __forceinline__
#define LAS __attribute__((address_space(3)))
typedef unsigned short bf16;
typedef short bf16x8 __attribute__((ext_vector_type(8)));
typedef short s16x4 __attribute__((ext_vector_type(4)));
typedef float f32x4 __attribute__((ext_vector_type(4)));
typedef float f32x16 __attribute__((ext_vector_type(16)));
typedef unsigned u32x4 __attribute__((ext_vector_type(4)));
typedef unsigned u32x2 __attribute__((ext_vector_type(2)));
constexpr int D = 2048, BATCH = 4, SEQ = 8192, T = BATCH * SEQ, DEPTH = 2, MEMLEN = 256;
constexpr int PROJW = 6168, PROJN = 6400;
constexpr int QAP = 2304, PROJP = 4224;
constexpr int O_QA = 0, O_KA = 768, O_VA = 1536, O_QB = 0, O_KB = 512, O_VB = 1024, O_FL = 1536, O_QC = 1544, O_KC = 1928, O_VC = 2312, O_RC = 3080, O_GL = 3848;
constexpr int DFF = 5504, CW = 512;
constexpr float LOG2E = 1.4426950408889634f, EPS = 1e-6f;
constexpr int NWAVES = 8, NTHR = 512;
constexpr int LDS_BYTES = 150528;
constexpr size_t MiB = 1u << 20;
constexpr size_t WS_CTL = 0, WS_C2 = 1 * MiB, WS_DEC = 2 * MiB, WS_LSE = 3 * MiB, WS_MEMN = 8 * MiB, WS_KVC = 12 * MiB;
constexpr size_t WS_WIN = 16 * MiB, WS_WOUT = 41 * MiB, WS_WCQ = 49 * MiB, WS_WCKV = 51 * MiB, WS_WCO = 55 * MiB, WS_WUP = 57 * MiB, WS_WDOWN = 100 * MiB;
constexpr size_t WS_XN = 122 * MiB, WS_QKVA = 250 * MiB, WS_PROJ = 394 * MiB, WS_ACT = 266 * MiB, WS_QC = 266 * MiB, WS_OC = 298 * MiB;
constexpr size_t WS_MIXED = 666 * MiB, WS_SC = 794 * MiB, WS_GL = 794 * MiB, WS_GF = 816 * MiB, WS_VF = 838 * MiB, WS_END = 938 * MiB;

DI float wave_sum(float v) {
#pragma unroll
    for (int o = 1; o < 64; o <<= 1) v += __shfl_xor(v, o);
    return v;
}
DI unsigned f2bf(float f) { unsigned u = __builtin_bit_cast(unsigned, f); return (u + 0x7fffu + ((u >> 16) & 1u)) >> 16; }
DI unsigned pk2(float lo, float hi) { return f2bf(lo) | (f2bf(hi) << 16); }
DI float bf2f(unsigned short b) { return __builtin_bit_cast(float, (unsigned)b << 16); }
DI float bflo(unsigned w) { return __builtin_bit_cast(float, w << 16); }
DI float bfhi(unsigned w) { return __builtin_bit_cast(float, w & 0xffff0000u); }
DI float logsig(float x) { return fminf(x, 0.f) - log1pf(expf(-fabsf(x))); }
DI int crow(int r, int hi) { return (r & 3) + 8 * (r >> 2) + 4 * hi; }
#define MFMA32(a, b, c) __builtin_amdgcn_mfma_f32_32x32x16_bf16((a), (b), (c), 0, 0, 0)
typedef short v4i16_t __attribute__((ext_vector_type(4)));
DI s16x4 trd(const LAS char* p) { return __builtin_bit_cast(s16x4, __builtin_amdgcn_ds_read_tr16_b64_v4i16((LAS v4i16_t*)p)); }
DI bf16x8 frag_row(const LAS char* base, int pitch, int row0, int k0, int lane) { return *(const LAS bf16x8*)(base + (row0 + (lane & 31)) * pitch + (k0 + 8 * (lane >> 5)) * 2); }
DI bf16x8 frag_tr(const LAS char* base, int pitch, int k0, int col0, int lane) {
    const int h = lane >> 5, blk = (lane >> 4) & 1, q = (lane & 15) >> 2, p = lane & 3;
    const LAS char* a = base + (k0 + 8 * h + q) * pitch + (col0 + 16 * blk) * 2 + 8 * p;
    const s16x4 lo = trd(a), hi = trd(a + 4 * pitch);
    return __builtin_shufflevector(lo, hi, 0, 1, 2, 3, 4, 5, 6, 7);
}
DI bf16x8 frag_tr_perm(const LAS char* base, int pitch, int k0, int col0, int lane) {
    const int h = lane >> 5, blk = (lane >> 4) & 1, q = (lane & 15) >> 2, p = lane & 3;
    const LAS char* a = base + (k0 + 4 * h + q) * pitch + (col0 + 16 * blk) * 2 + 8 * p;
    const s16x4 lo = trd(a), hi = trd(a + 8 * pitch);
    return __builtin_shufflevector(lo, hi, 0, 1, 2, 3, 4, 5, 6, 7);
}
typedef float f32x2_t __attribute__((ext_vector_type(2))); typedef __bf16 bf16x2_t __attribute__((ext_vector_type(2)));
DI unsigned cvtpk(float lo, float hi) { f32x2_t v = {lo, hi}; bf16x2_t b = __builtin_convertvector(v, bf16x2_t); return __builtin_bit_cast(unsigned, b); }
DI bf16x8 pack8(const f32x16& x, int s) { u32x4 p; p[0] = cvtpk(x[8 * s], x[8 * s + 1]); p[1] = cvtpk(x[8 * s + 2], x[8 * s + 3]); p[2] = cvtpk(x[8 * s + 4], x[8 * s + 5]); p[3] = cvtpk(x[8 * s + 6], x[8 * s + 7]); return __builtin_bit_cast(bf16x8, p); }

struct AttnU {
    const bf16* Qb; long qstride; const bf16* Kb; const bf16* Vb; long kstride; bf16* Ob; long ostride;
    int NT, t_begin;
    const float* cq; const float* ck; int q0;
    float* lse; long lstride;
};
template <int DH, int MODE>
DI void attn_unit(LAS char* lds, const AttnU& u, const LAS float* tbl) {
    constexpr int PITCH = DH * 2 + 16, TILEB = 64 * PITCH, BUFB = 2 * TILEB + 256, NCH = DH / 8, PER = NCH / 8;
    const int tid = otid(), lane = tid & 63, r32 = lane & 31, hi = lane >> 5; const int w = __builtin_amdgcn_readfirstlane(tid >> 6);
    bf16x8 qf[DH / 16];
    { const bf16* qrow = u.Qb + (long)(32 * w + r32) * u.qstride;
#pragma unroll
      for (int d0 = 0; d0 < DH / 16; ++d0) qf[d0] = *(const bf16x8*)(qrow + 16 * d0 + 8 * hi); }
    f32x16 o[DH / 32];
#pragma unroll
    for (int i = 0; i < DH / 32; ++i)
#pragma unroll
        for (int r = 0; r < 16; ++r) o[i][r] = 0.f;
    float m = -INFINITY, l = 0.f;
    u32x4 kreg[PER], vreg[PER]; float ckreg = 0.f;
    const int srow = (tid * PER) / NCH, sch = (tid * PER) % NCH;
#define AT_GLOAD(t) do { const long rr_ = (long)(64 * (t) + srow) * u.kstride + sch * 8; \
        _Pragma("unroll") for (int i_ = 0; i_ < PER; ++i_) { kreg[i_] = *(const u32x4*)(u.Kb + rr_ + 8 * i_); vreg[i_] = *(const u32x4*)(u.Vb + rr_ + 8 * i_); } \
        if (MODE == 1 && tid < 64) ckreg = u.ck[64 * (t) + tid]; } while (0)
#define AT_LWRITE(buf) do { LAS char* kb_ = lds + (buf) * BUFB + srow * PITCH + sch * 16; \
        _Pragma("unroll") for (int i_ = 0; i_ < PER; ++i_) { *(LAS u32x4*)(kb_ + 16 * i_) = kreg[i_]; *(LAS u32x4*)(kb_ + TILEB + 16 * i_) = vreg[i_]; } \
        if (MODE == 1 && tid < 64) *(LAS float*)(lds + (buf) * BUFB + 2 * TILEB + 4 * tid) = ckreg; } while (0)
    const int t0 = u.t_begin, NT = u.NT;
    AT_GLOAD(t0); AT_LWRITE(0); __syncthreads();
    for (int t = t0; t < NT; ++t) {
        const int cur = (t - t0) & 1;
        if (t + 1 < NT) AT_GLOAD(t + 1);
        const LAS char* Kt = lds + cur * BUFB; const LAS char* Vt = Kt + TILEB; const LAS float* ckl = (const LAS float*)(Kt + 2 * TILEB);
#pragma unroll
        for (int sub = 0; sub < 2; ++sub) {
            const int s = 2 * t + sub;
            bool active = true;
            if (MODE == 1) active = (32 * s <= u.q0 + 32 * w + 31);
            if (MODE == 2) active = (s >= w && s <= w + 4);
            if (active) {
                f32x16 p;
#pragma unroll
                for (int r = 0; r < 16; ++r) p[r] = 0.f;
#pragma unroll
                for (int d0 = 0; d0 < DH / 16; ++d0) { const bf16x8 kf = frag_row(Kt, PITCH, 32 * sub, 16 * d0, lane); p = MFMA32(kf, qf[d0], p); }
                if (MODE == 1) {
                    const bool diag = (32 * s + 31 > u.q0 + 32 * w);
                    const int qa = u.q0 + 32 * w + r32, kb = 32 * s + 4 * hi;
#pragma unroll
                    for (int g = 0; g < 4; ++g) { const f32x4 c4 = *(const LAS f32x4*)(ckl + 32 * sub + 8 * g + 4 * hi);
#pragma unroll
                        for (int e = 0; e < 4; ++e) p[4 * g + e] -= c4[e]; }
                    if (diag) {
#pragma unroll
                        for (int r = 0; r < 16; ++r) { const int ka = kb + (r & 3) + 8 * (r >> 2); p[r] = (ka <= qa) ? p[r] : -INFINITY; } }
                }
                if (MODE == 2) {
                    const LAS float* tb = tbl + (32 + 128 + 32 * w + r32 - 32 * s - 4 * hi);
#pragma unroll
                    for (int r = 0; r < 16; ++r) p[r] += tb[-((r & 3) + 8 * (r >> 2))];
                }
                float mx = p[0];
#pragma unroll
                for (int r = 1; r < 16; ++r) mx = fmaxf(mx, p[r]);
                mx = fmaxf(mx, __shfl_xor(mx, 32));
                const float mn = fmaxf(m, mx);
                if (__any(mn > m)) {
                    const float mr_ = (mn == -INFINITY) ? 0.f : mn;
                    const float alpha = __builtin_amdgcn_exp2f(m - mr_);
                    l *= alpha;
#pragma unroll
                    for (int i = 0; i < DH / 32; ++i)
#pragma unroll
                        for (int r = 0; r < 16; ++r) o[i][r] *= alpha;
                    m = mn;
                }
                const float mref = (m == -INFINITY) ? 0.f : m;
#pragma unroll
                for (int r = 0; r < 16; ++r) { p[r] = __builtin_amdgcn_exp2f(p[r] - mref); l += p[r]; }
                const bf16x8 pb0 = pack8(p, 0), pb1 = pack8(p, 1);
#pragma unroll
                for (int db = 0; db < DH / 32; ++db) {
                    const bf16x8 v0 = frag_tr_perm(Vt, PITCH, 32 * sub, 32 * db, lane), v1 = frag_tr_perm(Vt, PITCH, 32 * sub + 16, 32 * db, lane);
                    o[db] = MFMA32(v0, pb0, o[db]); o[db] = MFMA32(v1, pb1, o[db]);
                }
            }
        }
        if (t + 1 < NT) AT_LWRITE(cur ^ 1);
        __syncthreads();
    }
#undef AT_GLOAD
#undef AT_LWRITE
    l += __shfl_xor(l, 32);
    const float inv = 1.f / l;
    bf16* orow = u.Ob + (long)(32 * w + r32) * u.ostride;
#pragma unroll
    for (int db = 0; db < DH / 32; ++db)
#pragma unroll
        for (int g = 0; g < 4; ++g) { u32x2 wv; wv.x = cvtpk(o[db][4 * g] * inv, o[db][4 * g + 1] * inv); wv.y = cvtpk(o[db][4 * g + 2] * inv, o[db][4 * g + 3] * inv);
            *(u32x2*)(orow + 32 * db + 8 * g + 4 * hi) = wv; }
    if (MODE == 2 && hi == 0) u.lse[(long)(32 * w + r32) * u.lstride] = m + __log2f(l);
}
DI void norm_row_bf16(const float* xrow, const float* g, bf16* orow, int lane) {
    const f32x4* xr = (const f32x4*)xrow + lane; const f32x4* gr = (const f32x4*)g + lane;
    f32x4 v[8]; float s = 0.f;
#pragma unroll
    for (int j = 0; j < 8; ++j) { v[j] = xr[64 * j]; s += (v[j].x * v[j].x + v[j].y * v[j].y) + (v[j].z * v[j].z + v[j].w * v[j].w); }
    const float rstd = 1.f / sqrtf(wave_sum(s) * (1.f / D) + EPS);
    u32x2* o8 = (u32x2*)orow + lane;
#pragma unroll
    for (int j = 0; j < 8; ++j) { const f32x4 gg = gr[64 * j]; u32x2 w; w.x = pk2(v[j].x * rstd * gg.x, v[j].y * rstd * gg.y); w.y = pk2(v[j].z * rstd * gg.z, v[j].w * rstd * gg.w); o8[64 * j] = w; }
}
DI void xconv_row(const float* xrow, bf16* orow, unsigned long long* ssrow, int lane) {
    const f32x4* xr = (const f32x4*)xrow + lane;
    f32x4 v[8]; float s = 0.f;
#pragma unroll
    for (int j = 0; j < 8; ++j) { v[j] = xr[64 * j]; s += (v[j].x * v[j].x + v[j].y * v[j].y) + (v[j].z * v[j].z + v[j].w * v[j].w); }
    s = wave_sum(s); if (lane == 0) *ssrow = (unsigned long long)(s * 262144.f + 0.5f);
    u32x2* o8 = (u32x2*)orow + lane;
#pragma unroll
    for (int j = 0; j < 8; ++j) { u32x2 w; w.x = pk2(v[j].x, v[j].y); w.y = pk2(v[j].z, v[j].w); o8[64 * j] = w; }
}
DI void norm_row_out(const bf16* xrow, const float* g, float* orow, int lane) {
    const u32x4* xr = (const u32x4*)xrow + lane; const f32x4* gr = (const f32x4*)g; f32x4* o4 = (f32x4*)orow;
    float v[32]; float s = 0.f;
#pragma unroll
    for (int j = 0; j < 4; ++j) { const u32x4 w = xr[64 * j];
#pragma unroll
        for (int q = 0; q < 4; ++q) { v[8 * j + 2 * q] = bflo(w[q]); v[8 * j + 2 * q + 1] = bfhi(w[q]); s += v[8 * j + 2 * q] * v[8 * j + 2 * q] + v[8 * j + 2 * q + 1] * v[8 * j + 2 * q + 1]; } }
    const float rstd = 1.f / sqrtf(wave_sum(s) * (1.f / D) + EPS);
#pragma unroll
    for (int j = 0; j < 4; ++j) { const int c4 = (64 * j + lane) * 2;
        const f32x4 g0 = gr[c4], g1 = gr[c4 + 1];
        o4[c4] = (f32x4){v[8 * j] * rstd * g0.x, v[8 * j + 1] * rstd * g0.y, v[8 * j + 2] * rstd * g0.z, v[8 * j + 3] * rstd * g0.w};
        o4[c4 + 1] = (f32x4){v[8 * j + 4] * rstd * g1.x, v[8 * j + 5] * rstd * g1.y, v[8 * j + 6] * rstd * g1.z, v[8 * j + 7] * rstd * g1.w}; }
}
DI float win_scale(int n) {
    if (n < 768) return 0.125f * LOG2E;
    if (n >= 2304 && n < 2816) return 0.125f * LOG2E;
    if (n >= 3848 && n < 4232) return 0.10206207261596575f;
    return 1.f;
}
template <int MODE>
DI void wt_item(const float* W, int K, int N, bf16* WT, LAS float* scr, int item, int nblk, float sc, const float* gk, int lane) {
    const int kb = item / nblk, nb = item % nblk, k0 = 64 * kb, nd0 = 32 * nb;
    int ns0 = nd0;
    if (MODE == 2) { const int pn = nd0 >> 8, bj = (nd0 >> 7) & 1, j = nd0 & 127; ns0 = bj * DFF + 128 * pn + j; }
    { const int n4 = (lane & 7) * 4, nsrc = ns0 + n4; const bool ok = nsrc < N;
      f32x4 v[8];
#pragma unroll
      for (int i = 0; i < 8; ++i) { const int kk = (lane >> 3) + 8 * i; v[i] = ok ? *(const f32x4*)(W + (size_t)(k0 + kk) * N + nsrc) : (f32x4){0.f, 0.f, 0.f, 0.f}; }
#pragma unroll
      for (int i = 0; i < 8; ++i) { const int kk = (lane >> 3) + 8 * i; const float gsc = gk ? gk[k0 + kk] : 1.f; LAS float* d = scr + kk * 33 + n4;
          d[0] = v[i].x * gsc; d[1] = v[i].y * gsc; d[2] = v[i].z * gsc; d[3] = v[i].w * gsc; } }
    asm volatile("s_waitcnt lgkmcnt(0)" ::: "memory");
    const int c = lane & 7;
#pragma unroll
    for (int j = 0; j < 4; ++j) { const int n = (lane >> 3) + 8 * j; const LAS float* s = scr + (8 * c) * 33 + n;
        float f = sc; if (MODE == 1) f = win_scale(nd0 + n);
        u32x4 o; o.x = pk2(s[0 * 33] * f, s[1 * 33] * f); o.y = pk2(s[2 * 33] * f, s[3 * 33] * f); o.z = pk2(s[4 * 33] * f, s[5 * 33] * f); o.w = pk2(s[6 * 33] * f, s[7 * 33] * f);
        *(u32x4*)(WT + (size_t)(nd0 + n) * K + k0 + 8 * c) = o; }
    asm volatile("s_waitcnt lgkmcnt(0)" ::: "memory");
}
DI float logsig_fast(float x) { return fminf(x, 0.f) - __logf(1.f + __expf(-fabsf(x))); }
DI void fscan_chunk(LAS char* lds, int c, const bf16* PROJ, const float* fbias, float* C2, float* TOT) {
    LAS float* vals = (LAS float*)lds;
    const int tid = otid(), lane = tid & 63, w = tid >> 6;
    { const int t = tid >> 2, hq = tid & 3;
      const unsigned v = *(const unsigned*)(PROJ + ((size_t)c * 128 + t) * PROJP + O_FL + 2 * hq);
      vals[(2 * hq) * 128 + t] = logsig_fast(bflo(v) + fbias[2 * hq]) * LOG2E; vals[(2 * hq + 1) * 128 + t] = logsig_fast(bfhi(v) + fbias[2 * hq + 1]) * LOG2E; }
    __syncthreads();
    { const float a0 = vals[w * 128 + 2 * lane], a1 = vals[w * 128 + 2 * lane + 1]; const float sum = a0 + a1;
      float inc = sum;
#pragma unroll
      for (int o = 1; o < 64; o <<= 1) { const float nb = __shfl_up(inc, o); if (lane >= o) inc += nb; }
      const float ex = inc - sum;
      const int b = c >> 6, tb = (c & 63) * 128 + 2 * lane;
      float* dst = C2 + ((size_t)b * 8 + w) * SEQ + tb; dst[0] = ex + a0; dst[1] = ex + sum;
      if (lane == 63) TOT[c * 8 + w] = inc; }
    __syncthreads();
}
constexpr int G_OF = 0, G_BL = 0, G_QT = 49152, G_KT = 62464, G_VT = 75776, G_AM = 101376, G_SP = 110592, G_END = 148992;
constexpr int PQK = 208, PV = 400, PAM = 144;
static_assert(G_END <= LDS_BYTES, "gla lds");
template <int PH>
DI void gla_unit(LAS char* lds, int unit, const bf16* PROJ, const float* W2, const float* gb, bf16* SC, float* DEC, const float* cnorm, bf16* MIXED, bf16* QG, bf16* KG) {
    const int tid = otid(), lane = tid & 63, r32 = lane & 31, hi = lane >> 5; const int w = __builtin_amdgcn_readfirstlane(tid >> 6);
    const int bh = unit >> 7, n = unit & 127, b = bh >> 2, h = bh & 3;
    const size_t row0 = (size_t)b * SEQ + 64 * n;
    const int t = tid >> 3, kg = tid & 7;
    if (PH == 1) {
        LAS float* BL = (LAS float*)(lds + G_BL);
        u32x2 kv[3], qv[3];
        { const bf16* kp = PROJ + (row0 + t) * PROJP + O_KC + 96 * h + 12 * kg; const bf16* qp = PROJ + (row0 + t) * PROJP + O_QC + 96 * h + 12 * kg;
#pragma unroll
          for (int j = 0; j < 3; ++j) { kv[j] = *(const u32x2*)(kp + 4 * j); qv[j] = *(const u32x2*)(qp + 4 * j); } }
#pragma unroll
        for (int j = 0; j < 3; ++j) { const int c = tid + NTHR * j, tt = c / 24, ch = c - 24 * tt;
            *(LAS u32x4*)(lds + G_VT + tt * PV + ch * 16) = *(const u32x4*)(PROJ + (row0 + tt) * PROJP + O_VC + 192 * h + 8 * ch); }
        if (w < 3) {
            const int k = 32 * w + r32;
            bf16x8 bw; { u32x4 pw;
#pragma unroll
                for (int j = 0; j < 4; ++j) pw[j] = pk2(W2[(8 * hi + 2 * j) * 384 + 96 * h + k], W2[(8 * hi + 2 * j + 1) * 384 + 96 * h + k]);
                bw = __builtin_bit_cast(bf16x8, pw); }
            const float gbias = gb[96 * h + k];
            float carry = 0.f;
#pragma unroll
            for (int mi = 0; mi < 2; ++mi) {
                const bf16x8 ga = *(const bf16x8*)(PROJ + (row0 + 32 * mi + r32) * PROJP + O_GL + 8 * hi);
                f32x16 d;
#pragma unroll
                for (int r = 0; r < 16; ++r) d[r] = 0.f;
                d = MFMA32(ga, bw, d);
#pragma unroll
                for (int r = 0; r < 16; ++r) d[r] = logsig_fast(d[r] + gbias) * 0.0625f;
                float sg[4], ps[4];
#pragma unroll
                for (int g = 0; g < 4; ++g) { d[4 * g + 1] += d[4 * g]; d[4 * g + 2] += d[4 * g + 1]; d[4 * g + 3] += d[4 * g + 2]; sg[g] = d[4 * g + 3]; }
#pragma unroll
                for (int g = 0; g < 4; ++g) ps[g] = __shfl_xor(sg[g], 32);
                float base_ = carry;
#pragma unroll
                for (int g = 0; g < 4; ++g) { const float off = base_ + (hi ? ps[g] : 0.f);
#pragma unroll
                    for (int e = 0; e < 4; ++e) d[4 * g + e] += off;
                    base_ += sg[g] + ps[g]; }
                carry = base_;
#pragma unroll
                for (int r = 0; r < 16; ++r) BL[(32 * mi + crow(r, hi)) * 96 + k] = d[r];
            }
        }
        __syncthreads();
        { bf16* qg = QG + (row0 + t) * 384 + 96 * h + 12 * kg; bf16* kgp = KG + (row0 + t) * 384 + 96 * h + 12 * kg;
#pragma unroll
          for (int j = 0; j < 3; ++j) {
              float bb[4], bl[4];
#pragma unroll
              for (int e = 0; e < 4; ++e) { bb[e] = BL[t * 96 + 12 * kg + 4 * j + e]; bl[e] = BL[63 * 96 + 12 * kg + 4 * j + e]; }
              const float k0 = bflo(kv[j].x), k1 = bfhi(kv[j].x), k2 = bflo(kv[j].y), k3 = bfhi(kv[j].y);
              u32x2 o; o.x = pk2(k0 * __expf(bl[0] - bb[0]), k1 * __expf(bl[1] - bb[1])); o.y = pk2(k2 * __expf(bl[2] - bb[2]), k3 * __expf(bl[3] - bb[3]));
              *(LAS u32x2*)(lds + G_KT + t * PQK + (12 * kg + 4 * j) * 2) = o;
              u32x2 ok; ok.x = pk2(k0 * __expf(-bb[0]), k1 * __expf(-bb[1])); ok.y = pk2(k2 * __expf(-bb[2]), k3 * __expf(-bb[3]));
              *(u32x2*)(kgp + 4 * j) = ok;
              u32x2 oq; oq.x = pk2(bflo(qv[j].x) * __expf(bb[0]), bfhi(qv[j].x) * __expf(bb[1])); oq.y = pk2(bflo(qv[j].y) * __expf(bb[2]), bfhi(qv[j].y) * __expf(bb[3]));
              *(u32x2*)(qg + 4 * j) = oq;
          } }
        if (tid < 96) DEC[(size_t)unit * 96 + tid] = __expf(BL[63 * 96 + tid]);
        __syncthreads();
        bf16* dst = SC + (size_t)unit * 18432;
        for (int tile = w; tile < 18; tile += 8) { const int mi = tile / 6, ni = tile - 6 * mi;
            f32x16 c;
#pragma unroll
            for (int r = 0; r < 16; ++r) c[r] = 0.f;
#pragma unroll
            for (int s = 0; s < 4; ++s) { const bf16x8 a = frag_tr(lds + G_KT, PQK, 16 * s, 32 * mi, lane), bq = frag_tr(lds + G_VT, PV, 16 * s, 32 * ni, lane); c = MFMA32(a, bq, c); }
#pragma unroll
            for (int g = 0; g < 4; ++g) { u32x2 o; o.x = pk2(c[4 * g], c[4 * g + 1]); o.y = pk2(c[4 * g + 2], c[4 * g + 3]);
                *(u32x2*)(dst + (32 * ni + r32) * 96 + 32 * mi + 8 * g + 4 * hi) = o; } }
    } else {
        { const bf16* qg = QG + (row0 + t) * 384 + 96 * h + 12 * kg; const bf16* kgp = KG + (row0 + t) * 384 + 96 * h + 12 * kg;
#pragma unroll
          for (int j = 0; j < 3; ++j) { *(LAS u32x2*)(lds + G_QT + t * PQK + (12 * kg + 4 * j) * 2) = *(const u32x2*)(qg + 4 * j); *(LAS u32x2*)(lds + G_KT + t * PQK + (12 * kg + 4 * j) * 2) = *(const u32x2*)(kgp + 4 * j); } }
#pragma unroll
        for (int j = 0; j < 3; ++j) { const int c = tid + NTHR * j, tt = c / 24, ch = c - 24 * tt;
            *(LAS u32x4*)(lds + G_VT + tt * PV + ch * 16) = *(const u32x4*)(PROJ + (row0 + tt) * PROJP + O_VC + 192 * h + 8 * ch); }
        const bf16* src = SC + (size_t)unit * 18432;
#pragma unroll
        for (int j = 0; j < 5; ++j) { const int c = tid + NTHR * j; if (c < 2304) *(LAS u32x4*)(lds + G_SP + c * 16) = *(const u32x4*)(src + c * 8); }
        __syncthreads();
        if (w < 4) { const int mi = w >> 1, nj = w & 1;
            f32x16 c;
#pragma unroll
            for (int r = 0; r < 16; ++r) c[r] = 0.f;
#pragma unroll
            for (int s = 0; s < 6; ++s) { const bf16x8 a = frag_row(lds + G_QT, PQK, 32 * mi, 16 * s, lane), bq = frag_row(lds + G_KT, PQK, 32 * nj, 16 * s, lane); c = MFMA32(a, bq, c); }
#pragma unroll
            for (int r = 0; r < 16; ++r) { const int i = 32 * mi + crow(r, hi), j = 32 * nj + r32; const float val = (j <= i) ? c[r] : 0.f;
                *(LAS unsigned short*)(lds + G_AM + i * PAM + j * 2) = (unsigned short)f2bf(val); } }
        __syncthreads();
        LAS float* OF = (LAS float*)(lds + G_OF);
        for (int tile = w; tile < 12; tile += 8) { const int mi = tile / 6, ni = tile - 6 * mi;
            f32x16 c;
#pragma unroll
            for (int r = 0; r < 16; ++r) c[r] = 0.f;
#pragma unroll
            for (int s = 0; s < 6; ++s) { const bf16x8 a = frag_row(lds + G_QT, PQK, 32 * mi, 16 * s, lane), bq = frag_row(lds + G_SP, 192, 32 * ni, 16 * s, lane); c = MFMA32(a, bq, c); }
#pragma unroll
            for (int s = 0; s < 4; ++s) { const bf16x8 a = frag_row(lds + G_AM, PAM, 32 * mi, 16 * s, lane), bq = frag_tr(lds + G_VT, PV, 16 * s, 32 * ni, lane); c = MFMA32(a, bq, c); }
#pragma unroll
            for (int r = 0; r < 16; ++r) OF[(32 * mi + crow(r, hi)) * 192 + 32 * ni + r32] = c[r]; }
        __syncthreads();
        { const int i = tid >> 3, part = tid & 7;
          const LAS float* orow = OF + i * 192 + 24 * part;
          float ov[24]; float ss = 0.f;
#pragma unroll
          for (int j = 0; j < 24; ++j) { ov[j] = orow[j]; ss += ov[j] * ov[j]; }
          ss += __shfl_xor(ss, 1); ss += __shfl_xor(ss, 2); ss += __shfl_xor(ss, 4);
          const float rstd = 1.f / sqrtf(ss * (1.f / 192.f) + EPS);
          const bf16* rcp = PROJ + (row0 + i) * PROJP + O_RC + 192 * h + 24 * part;
          bf16* op = MIXED + (row0 + i) * D + 1280 + 192 * h + 24 * part;
          const float* cn = cnorm + 24 * part;
#pragma unroll
          for (int q = 0; q < 3; ++q) { const u32x4 rv = *(const u32x4*)(rcp + 8 * q); u32x4 o;
#pragma unroll
              for (int e = 0; e < 4; ++e) { const float r0 = bflo(rv[e]), r1 = bfhi(rv[e]);
                  const float y0 = ov[8 * q + 2 * e] * rstd * cn[8 * q + 2 * e] * (r0 / (1.f + __expf(-r0))), y1 = ov[8 * q + 2 * e + 1] * rstd * cn[8 * q + 2 * e + 1] * (r1 / (1.f + __expf(-r1)));
                  o[e] = pk2(y0, y1); }
              *(u32x4*)(op + 8 * q) = o; } }
    }
    __syncthreads();
}
struct DilU { const bf16* Qb; const bf16* Kb; bf16* Ob; float* lse; int qstride, kstride, ostride, lstride, row_lo; };
constexpr int DIL_PITCH = 144, DIL_KB = 0, DIL_VB = 384 * DIL_PITCH;
static_assert(2 * 384 * DIL_PITCH + 36 * 192 * 4 <= 149504, "dilated lds");
struct DilRegs { u32x4 k[6], v[6]; bf16x8 q[4]; };
constexpr int DIL_TBLS = 2 * 384 * DIL_PITCH;
#define DIL_GLOAD(U, RG) do { _Pragma("unroll") for (int i_ = 0; i_ < 6; ++i_) { const int c_ = tid + NTHR * i_, row_ = c_ >> 3, ch_ = c_ & 7; \
        if (row_ >= (U).row_lo) { const bf16* p_ = (U).Kb + (long)row_ * (U).kstride + 8 * ch_; RG.k[i_] = *(const u32x4*)p_; RG.v[i_] = *(const u32x4*)(p_ + (O_VA - O_KA)); } } \
        { const bf16* qrow_ = (U).Qb + (long)(tid >> 1 & ~31 | (tid & 31)) * (U).qstride; _Pragma("unroll") for (int d0_ = 0; d0_ < 4; ++d0_) RG.q[d0_] = *(const bf16x8*)(qrow_ + 16 * d0_ + 8 * ((tid >> 5) & 1)); } } while (0)
#define DIL_LWRITE(RG) do { _Pragma("unroll") for (int i_ = 0; i_ < 6; ++i_) { const int c_ = tid + NTHR * i_, row_ = c_ >> 3, ch_ = c_ & 7; \
        *(LAS u32x4*)(lds + DIL_KB + row_ * DIL_PITCH + 16 * ch_) = RG.k[i_]; *(LAS u32x4*)(lds + DIL_VB + row_ * DIL_PITCH + 16 * ch_) = RG.v[i_]; } } while (0)
DI void dil_compute(LAS char* lds, const DilU& u, const LAS float* tbl, int tid, const bf16x8 (&qf)[4]) {
    const int lane = tid & 63, r32 = lane & 31, hi = lane >> 5; const int w = __builtin_amdgcn_readfirstlane(tid >> 6);
    f32x16 o[2];
#pragma unroll
    for (int i = 0; i < 2; ++i)
#pragma unroll
        for (int r = 0; r < 16; ++r) o[i][r] = 0.f;
    float m = -INFINITY, l = 0.f;
    for (int a = 0; a < 5; ++a) {
        const int s = w + a;
        if (32 * s < u.row_lo) continue;
        const LAS char* Kt = lds + DIL_KB + 32 * s * DIL_PITCH; const LAS char* Vt = lds + DIL_VB + 32 * s * DIL_PITCH;
        f32x16 p;
#pragma unroll
        for (int r = 0; r < 16; ++r) p[r] = 0.f;
#pragma unroll
        for (int d0 = 0; d0 < 4; ++d0) { const bf16x8 kf = frag_row(Kt, DIL_PITCH, 0, 16 * d0, lane); p = MFMA32(kf, qf[d0], p); }
        { const LAS float* tb = tbl + (32 + 128 + r32 - 32 * a - 4 * hi);
#pragma unroll
          for (int r = 0; r < 16; ++r) p[r] += tb[-((r & 3) + 8 * (r >> 2))]; }
        float mx = p[0];
#pragma unroll
        for (int r = 1; r < 16; ++r) mx = fmaxf(mx, p[r]);
        mx = fmaxf(mx, __shfl_xor(mx, 32));
        const float mn = fmaxf(m, mx);
        if (__any(mn > m)) {
            const float mr_ = (mn == -INFINITY) ? 0.f : mn;
            const float alpha = __builtin_amdgcn_exp2f(m - mr_);
            l *= alpha;
#pragma unroll
            for (int i = 0; i < 2; ++i)
#pragma unroll
                for (int r = 0; r < 16; ++r) o[i][r] *= alpha;
            m = mn;
        }
        const float mref = (m == -INFINITY) ? 0.f : m;
#pragma unroll
        for (int r = 0; r < 16; ++r) { p[r] = __builtin_amdgcn_exp2f(p[r] - mref); l += p[r]; }
        const bf16x8 pb0 = pack8(p, 0), pb1 = pack8(p, 1);
#pragma unroll
        for (int db = 0; db < 2; ++db) {
            const bf16x8 v0 = frag_tr_perm(Vt, DIL_PITCH, 0, 32 * db, lane), v1 = frag_tr_perm(Vt, DIL_PITCH, 16, 32 * db, lane);
            o[db] = MFMA32(v0, pb0, o[db]); o[db] = MFMA32(v1, pb1, o[db]);
        }
    }
    l += __shfl_xor(l, 32);
    const float inv = 1.f / l;
    bf16* orow = u.Ob + (long)(32 * w + r32) * u.ostride;
#pragma unroll
    for (int db = 0; db < 2; ++db)
#pragma unroll
        for (int g = 0; g < 4; ++g) { u32x2 wv; wv.x = cvtpk(o[db][4 * g] * inv, o[db][4 * g + 1] * inv); wv.y = cvtpk(o[db][4 * g + 2] * inv, o[db][4 * g + 3] * inv);
            *(u32x2*)(orow + 32 * db + 8 * g + 4 * hi) = wv; }
    if (hi == 0) u.lse[(long)(32 * w + r32) * u.lstride] = m + __log2f(l);
}
#include <hip/hip_bf16.h>
namespace attn_body {
using bf16=__hip_bfloat16;
using bf16x8=__attribute__((ext_vector_type(8)))short;
using s16x4=__attribute__((ext_vector_type(4)))short;
using f32x16=__attribute__((ext_vector_type(16)))float;
using u32x4=__attribute__((ext_vector_type(4)))unsigned;
constexpr int SEQ=8192,D=64,DM=4224,DMO=2048;
constexpr int NW=8,QBLK=32,QB=QBLK*NW,KVBLK=64,NQB=SEQ/QB;
__device__ __forceinline__ int crow(int r,int hi){return (r&3)+8*(r>>2)+4*hi;}
#define SBAR() __builtin_amdgcn_sched_barrier(0)
__device__ __forceinline__ void cmask(f32x16&p0,f32x16&p1,int jb,int qrel,int hi){
  const float NEG=-INFINITY; int kb=64*jb+4*hi;
  #pragma unroll
  for(int r=0;r<16;++r){int kv=kb+(r&3)+8*(r>>2); if(kv>qrel)p0[r]=NEG; if(kv+32>qrel)p1[r]=NEG;}
}

constexpr int NSLOT=3, SLOTB=8192;
constexpr int LDS_K=0, LDS_V=NSLOT*SLOTB, LDS_WS=2*NSLOT*SLOTB, LDS_OST=LDS_WS+NW*64*4, LDS_CK=LDS_OST+NW*4096, LDS_BYTES=LDS_CK+SEQ*4;
constexpr float C2=0.125f*1.4426950408889634f;
__device__ __forceinline__ void glds16(const void*gsrc,unsigned lds_dst){unsigned keep;
  asm volatile("s_mov_b32 %0, m0\n\ts_mov_b32 m0, %2\n\ts_nop 0\n\tglobal_load_lds_dwordx4 %1, off\n\ts_mov_b32 m0, %0":"=&s"(keep):"v"(gsrc),"s"(lds_dst):"memory");}
__device__ __forceinline__ float max3f(float a,float b,float c){float r;asm("v_max3_f32 %0, %1, %2, %3":"=v"(r):"v"(a),"v"(b),"v"(c));return r;}
__device__ __forceinline__ float max2f(float a,float b){float r;asm("v_max_f32_e32 %0, %1, %2":"=v"(r):"v"(a),"v"(b));return r;}
__device__ __forceinline__ float fadd_s(float a,float b){float r;asm("v_add_f32_e32 %0, %1, %2":"=v"(r):"v"(a),"v"(b));return r;}
__device__ __forceinline__ float fsub_s(float a,float b){float r;asm("v_sub_f32_e32 %0, %1, %2":"=v"(r):"v"(a),"v"(b));return r;}
typedef float f32x2_t __attribute__((ext_vector_type(2))); typedef __bf16 bf16x2_t __attribute__((ext_vector_type(2)));
__device__ __forceinline__ unsigned cvtpk_s(float lo,float hi){f32x2_t v={lo,hi};bf16x2_t b=__builtin_convertvector(v,bf16x2_t);return __builtin_bit_cast(unsigned,b);}
#define WAIT_BAR(N) asm volatile("s_waitcnt vmcnt(" #N ") lgkmcnt(0)\n\ts_barrier":::"memory")

__device__ __forceinline__ void qkt(f32x16&p0,f32x16&p1,const char*Kslot,const bf16x8*qr,const f32x16&negm,int r32,int hi){
  const char*kb=Kslot+hi*1024+r32*16;
  #pragma unroll
  for(int d0=0;d0<4;++d0){
    const bf16x8 b0=*reinterpret_cast<const bf16x8*>(kb+d0*2048);
    const bf16x8 b1=*reinterpret_cast<const bf16x8*>(kb+d0*2048+512);
    if(d0==0){p0=__builtin_amdgcn_mfma_f32_32x32x16_bf16(b0,qr[0],negm,0,0,0);p1=__builtin_amdgcn_mfma_f32_32x32x16_bf16(b1,qr[0],negm,0,0,0);}
    else{p0=__builtin_amdgcn_mfma_f32_32x32x16_bf16(b0,qr[d0],p0,0,0,0);p1=__builtin_amdgcn_mfma_f32_32x32x16_bf16(b1,qr[d0],p1,0,0,0);}}
}
typedef __attribute__((address_space(3))) const char* lds_cptr;
typedef short v4i16_t __attribute__((ext_vector_type(4)));
__device__ __forceinline__ void kload8(bf16x8*kf,lds_cptr kp){
  kf[0]=*(const __attribute__((address_space(3))) bf16x8*)(kp);      kf[1]=*(const __attribute__((address_space(3))) bf16x8*)(kp+512);
  kf[2]=*(const __attribute__((address_space(3))) bf16x8*)(kp+2048); kf[3]=*(const __attribute__((address_space(3))) bf16x8*)(kp+2560);
  kf[4]=*(const __attribute__((address_space(3))) bf16x8*)(kp+4096); kf[5]=*(const __attribute__((address_space(3))) bf16x8*)(kp+4608);
  kf[6]=*(const __attribute__((address_space(3))) bf16x8*)(kp+6144); kf[7]=*(const __attribute__((address_space(3))) bf16x8*)(kp+6656);
}
__device__ __forceinline__ void kload2(bf16x8*kf,lds_cptr kp,int j){ kf[2*j]=*(const __attribute__((address_space(3))) bf16x8*)(kp+j*2048); kf[2*j+1]=*(const __attribute__((address_space(3))) bf16x8*)(kp+j*2048+512); }
__device__ __forceinline__ s16x4 vtr(lds_cptr p){ return __builtin_bit_cast(s16x4,__builtin_amdgcn_ds_read_tr16_b64_v4i16((__attribute__((address_space(3))) v4i16_t*)p)); }
__device__ __forceinline__ float rowmax(const f32x16&p0,const f32x16&p1){
  float a=max3f(p0[0],p0[1],p1[0]),b=max3f(p0[2],p0[3],p1[1]);a=max3f(a,p1[2],p1[3]);
  #pragma unroll
  for(int r=4;r<16;r+=4){a=max3f(a,p0[r],p0[r+1]);b=max3f(b,p0[r+2],p0[r+3]);a=max3f(a,p1[r],p1[r+1]);b=max3f(b,p1[r+2],p1[r+3]);}
  const float m=max2f(a,b);
  auto rr=__builtin_amdgcn_permlane32_swap(__float_as_uint(m),__float_as_uint(m),false,false);
  return max2f(__uint_as_float(rr[0]),__uint_as_float(rr[1]));
}
__device__ __forceinline__ void pv(f32x16*o,int vb,bf16x8 pa0,bf16x8 pa1,bf16x8 pa2,bf16x8 pa3){
  #pragma unroll
  for(int d0=0;d0<2;++d0){s16x4 lo[4],hi[4];
    #pragma unroll
    for(int ks=0;ks<4;++ks){
      asm volatile("ds_read_b64_tr_b16 %0,%1 offset:%c2":"=&v"(lo[ks]):"v"(vb),"i"(d0*4096+ks*1024):"memory");
      asm volatile("ds_read_b64_tr_b16 %0,%1 offset:%c2":"=&v"(hi[ks]):"v"(vb),"i"(d0*4096+ks*1024+512):"memory");}
    asm volatile("s_waitcnt lgkmcnt(0)":::"memory");SBAR();
    #define PK(k) (bf16x8){lo[k][0],lo[k][1],lo[k][2],lo[k][3],hi[k][0],hi[k][1],hi[k][2],hi[k][3]}
    o[d0]=__builtin_amdgcn_mfma_f32_32x32x16_bf16(pa0,PK(0),o[d0],0,0,0);
    o[d0]=__builtin_amdgcn_mfma_f32_32x32x16_bf16(pa1,PK(1),o[d0],0,0,0);
    o[d0]=__builtin_amdgcn_mfma_f32_32x32x16_bf16(pa2,PK(2),o[d0],0,0,0);
    o[d0]=__builtin_amdgcn_mfma_f32_32x32x16_bf16(pa3,PK(3),o[d0],0,0,0);
    #undef PK
  }
}

#ifndef ATTN_STORE16
#define ATTN_STORE16(p,v) (*(u32x4*)(p)=(v))
#endif
typedef float f32x4v __attribute__((ext_vector_type(4)));
template<int THRL> __device__ __forceinline__ void attn_unit(int b,int h,int qb,const bf16*Q,const bf16*__restrict__ K,const bf16*__restrict__ V,bf16*O,const float*__restrict__ ckg,const float*__restrict__ ckoff,int ts,char*shm){
  const int tid=otid(),lane=tid&63,r32=lane&31,hi=lane>>5; const int wid=__builtin_amdgcn_readfirstlane(tid>>6);
  const long rowbase=(long)b*SEQ; const int q0=qb*QB;
  const bf16*Qw=Q+(rowbase+q0+wid*QBLK)*DM+h*D;
  const bf16*Kh=K+(rowbase+(long)ts*KVBLK)*DM+h*D,*Vh=V+(rowbase+(long)ts*KVBLK)*DM+h*D;
  const lds_cptr shm3=(lds_cptr)shm;
  const unsigned lds0=(unsigned)(uintptr_t)shm;
  float*wsf=(float*)(shm+LDS_WS)+wid*64;
  const bf16*ksrc=Kh+(long)lane*DM+wid*8;
  const bf16*vsrc=Vh+(long)(16*(wid&3)+(lane>>2))*DM+(wid>>2)*32+(lane&3)*8;
  const unsigned kdst=lds0+LDS_K+wid*1024, vdst=lds0+LDS_V+wid*1024;
  #define DMA_K(t,slot) glds16(ksrc+(long)(t)*KVBLK*DM,(unsigned)__builtin_amdgcn_readfirstlane(kdst+(slot)))
  #define DMA_V(t,slot) glds16(vsrc+(long)(t)*KVBLK*DM,(unsigned)__builtin_amdgcn_readfirstlane(vdst+(slot)))
  const int vb0=(int)(lds0+LDS_V)+((lane>>4)&1)*32+(lane&3)*8+(4*hi+((lane&15)>>2))*64;
  const char*Kbase=shm+LDS_K; bf16x8 kf[8];
  const lds_cptr kp0=shm3+LDS_K+hi*1024+r32*16; const lds_cptr vp0=shm3+LDS_V+((lane>>4)&1)*32+(lane&3)*8+(4*hi+((lane&15)>>2))*64;
  const int NT=(q0+QB)/KVBLK-ts;
  { __attribute__((address_space(3))) float*ckw=(__attribute__((address_space(3))) float*)(shm3+LDS_CK); const int nck=NT*KVBLK, kofs=ts*KVBLK; float cv[16];
    _Pragma("unroll") for(int j_=0;j_<16;++j_){const int i=tid+NW*64*j_; cv[j_]=(i<nck)?ckg[i+kofs]+ckoff[((i+kofs)>>7)*8]:0.f;}
    _Pragma("unroll") for(int j_=0;j_<16;++j_){const int i=tid+NW*64*j_; if(i<nck)ckw[i]=cv[j_];} }
  DMA_K(0,0);DMA_V(0,0);DMA_K(1,SLOTB);
  bf16x8 qr[4];
  #pragma unroll
  for(int d0=0;d0<4;++d0)qr[d0]=*reinterpret_cast<const bf16x8*>(&Qw[(long)r32*DM+d0*16+hi*8]);
  float mhat=0.f,l_reg=0.f;f32x16 o[2];o[0]=f32x16{};o[1]=f32x16{};f32x16 negm=f32x16{};asm volatile("":"+v"(negm));
  const int qrel=wid*QBLK+r32;
  #define CMASK(P0,P1,t) do{int jb_=(t)-(NT-4); if(jb_>=0)cmask(P0,P1,jb_,qrel,hi);}while(0)
  const __attribute__((address_space(3))) float*ckl3=(const __attribute__((address_space(3))) float*)(shm3+LDS_CK)+4*hi;
  #define BIAS(P0,P1,t) do{ const __attribute__((address_space(3))) float*cb_=ckl3+64*(t); \
    _Pragma("unroll") for(int g_=0;g_<4;++g_){ const f32x4v a_=*(const __attribute__((address_space(3))) f32x4v*)(cb_+8*g_), b_=*(const __attribute__((address_space(3))) f32x4v*)(cb_+32+8*g_); \
      _Pragma("unroll") for(int e_=0;e_<4;++e_){ P0[4*g_+e_]-=a_[e_]; P1[4*g_+e_]-=b_[e_]; } } }while(0)
  bool resc=false;
  #define START(P0,P1) do{ const float rm=rowmax(P0,P1); resc=false; \
    { const float dl=rm; mhat=fadd_s(mhat,dl); \
      _Pragma("unroll") for(int r=0;r<16;++r){P0[r]=fsub_s(P0[r],dl);P1[r]=fsub_s(P1[r],dl);} \
      _Pragma("unroll") for(int r=0;r<16;++r)negm[r]=-mhat; asm volatile("":"+v"(negm)); } \
    _Pragma("unroll") for(int r=0;r<16;++r)P0[r]=__builtin_amdgcn_exp2f(P0[r]); }while(0)
  #define RESC() do{ if(resc){ asm volatile("s_waitcnt lgkmcnt(0)":::"memory"); \
      _Pragma("unroll") for(int d_=0;d_<2;++d_) _Pragma("unroll") for(int r=0;r<16;++r)o[d_][r]*=wsf[crow(r,hi)]; } }while(0)
  f32x16 pA0,pA1,pB0,pB1;
  int sl_prev=0,sl_cur=0,sl_next=SLOTB;
  #define ROT() do{sl_prev=sl_cur;sl_cur=sl_next;sl_next=(sl_next==(NSLOT-1)*SLOTB)?0:sl_next+SLOTB;}while(0)
  DMA_K(2,2*SLOTB);
  WAIT_BAR(3);
  qkt(pA0,pA1,Kbase,qr,negm,r32,hi);asm volatile("s_nop 15\n\ts_nop 7":"+v"(pA0),"+v"(pA1));CMASK(pA0,pA1,0);BIAS(pA0,pA1,0);
  START(pA0,pA1);
  _Pragma("unroll") for(int r=0;r<16;++r)pA1[r]=__builtin_amdgcn_exp2f(pA1[r]);
  WAIT_BAR(0);
  DMA_K(3,0);DMA_V(1,SLOTB);
  ROT();
  kload8(kf,kp0+sl_cur);
  WAIT_BAR(2);
  s16x4 vlo[8],vhi[8]; u32x4 pw0,pw1,pw2,pw3;
  #define PKW(P,B) cvtpk_s(P[B],P[B+1])
  #define PAF(k) __builtin_bit_cast(bf16x8,pw##k)
  #define VFR(i) (bf16x8){vlo[i][0],vlo[i][1],vlo[i][2],vlo[i][3],vhi[i][0],vhi[i][1],vhi[i][2],vhi[i][3]}
  #define PIN(x) asm volatile("":"+v"(x))
  #define MX3(a,b,c) __builtin_fmaxf(__builtin_fmaxf((a),(b)),(c))
  #define GAPA(MF,A0,A1,A2,A3,W0,W1,PW) do{ MF; sacc+=A0; sacc+=A1; sacc+=A2; sacc+=A3; PIN(sacc); W0; W1; PIN(PW); SBAR(); }while(0)
  #define EX(v) __builtin_amdgcn_exp2f(v)
  #define GAPB(MF,X,B) do{ MF; X[B]=EX(X[B]); X[B+1]=EX(X[B+1]); X[B+2]=EX(X[B+2]); X[B+3]=EX(X[B+3]); PIN(X); SBAR(); }while(0)
  #define VRD(i) do{ vlo[i]=vtr(vp_+(((i)>>2)*4096+((i)&3)*1024)); vhi[i]=vtr(vp_+(((i)>>2)*4096+((i)&3)*1024+512)); }while(0)
  #define KRD(G,j) do{ if(G){ kload2(kf,kp0+sl_next,j); SBAR(); } }while(0)
  #define STEP(C0,C1,P0,P1,t,GK,GV,GL) do{ SBAR(); \
    const lds_cptr vp_=vp0+sl_prev; \
    VRD(0); SBAR(); float sacc=(P0[0]+P0[1]); \
    GAPA(C0=__builtin_amdgcn_mfma_f32_32x32x16_bf16(kf[0],qr[0],negm,0,0,0), P0[2],P0[3],P0[4],P0[5],     pw0[0]=PKW(P0,0), pw0[1]=PKW(P0,2), pw0); \
    VRD(4); SBAR(); GAPA(C1=__builtin_amdgcn_mfma_f32_32x32x16_bf16(kf[1],qr[0],negm,0,0,0), P0[6],P0[7],P0[8],P0[9],     pw0[2]=PKW(P0,4), pw0[3]=PKW(P0,6), pw0); \
    VRD(1); SBAR(); GAPA(C0=__builtin_amdgcn_mfma_f32_32x32x16_bf16(kf[2],qr[1],C0,0,0,0),   P0[10],P0[11],P0[12],P0[13], pw1[0]=PKW(P0,8), pw1[1]=PKW(P0,10), pw1); \
    VRD(5); SBAR(); GAPA(C1=__builtin_amdgcn_mfma_f32_32x32x16_bf16(kf[3],qr[1],C1,0,0,0),   P0[14],P0[15],P1[0],P1[1],   pw1[2]=PKW(P0,12),pw1[3]=PKW(P0,14), pw1); \
    VRD(2); SBAR(); GAPA(C0=__builtin_amdgcn_mfma_f32_32x32x16_bf16(kf[4],qr[2],C0,0,0,0),   P1[2],P1[3],P1[4],P1[5],     pw2[0]=PKW(P1,0), pw2[1]=PKW(P1,2), pw2); \
    VRD(6); SBAR(); GAPA(C1=__builtin_amdgcn_mfma_f32_32x32x16_bf16(kf[5],qr[2],C1,0,0,0),   P1[6],P1[7],P1[8],P1[9],     pw2[2]=PKW(P1,4), pw2[3]=PKW(P1,6), pw2); \
    VRD(3); SBAR(); GAPA(C0=__builtin_amdgcn_mfma_f32_32x32x16_bf16(kf[6],qr[3],C0,0,0,0),   P1[10],P1[11],P1[12],P1[13], pw3[0]=PKW(P1,8), pw3[1]=PKW(P1,10), pw3); \
    VRD(7); SBAR(); GAPA(C1=__builtin_amdgcn_mfma_f32_32x32x16_bf16(kf[7],qr[3],C1,0,0,0),   P1[14],P1[15],0.f,0.f,       pw3[2]=PKW(P1,12),pw3[3]=PKW(P1,14), pw3); \
    l_reg+=sacc; \
    if(GK){DMA_K((t)+3,sl_cur);} if(GV){DMA_V((t)+1,sl_next);} \
    CMASK(C0,C1,t); BIAS(C0,C1,t); \
    { float a=MX3(C0[0],C0[1],C1[0]),b=MX3(C0[2],C0[3],C1[1]); a=MX3(a,C1[2],C1[3]); \
      _Pragma("unroll") for(int r=4;r<16;r+=4){a=MX3(a,C0[r],C0[r+1]);b=MX3(b,C0[r+2],C0[r+3]);a=MX3(a,C1[r],C1[r+1]);b=MX3(b,C1[r+2],C1[r+3]);} \
      float rm=__builtin_fmaxf(a,b); { auto rr=__builtin_amdgcn_permlane32_swap(__float_as_uint(rm),__float_as_uint(rm),false,false); rm=__builtin_fmaxf(__uint_as_float(rr[0]),__uint_as_float(rr[1])); } \
      resc=false; \
      if(__builtin_expect(__any(rm>(float)THRL),0)){ const float dl=__builtin_fmaxf(rm,0.f); mhat+=dl; \
        _Pragma("unroll") for(int r=0;r<16;++r){C0[r]-=dl;C1[r]-=dl;} \
        _Pragma("unroll") for(int r=0;r<16;++r)negm[r]=-mhat; asm volatile("":"+v"(negm)); \
        const float f=__builtin_amdgcn_exp2f(-dl); l_reg*=f; if(hi==0)wsf[r32]=f; resc=true; } } \
    SBAR(); \
    GAPB(o[0]=__builtin_amdgcn_mfma_f32_32x32x16_bf16(PAF(0),VFR(0),o[0],0,0,0), C0,0); \
    GAPB(o[1]=__builtin_amdgcn_mfma_f32_32x32x16_bf16(PAF(0),VFR(4),o[1],0,0,0), C0,4); \
    KRD(GL,0); GAPB(o[0]=__builtin_amdgcn_mfma_f32_32x32x16_bf16(PAF(1),VFR(1),o[0],0,0,0), C0,8); \
    KRD(GL,1); GAPB(o[1]=__builtin_amdgcn_mfma_f32_32x32x16_bf16(PAF(1),VFR(5),o[1],0,0,0), C0,12); \
    KRD(GL,2); GAPB(o[0]=__builtin_amdgcn_mfma_f32_32x32x16_bf16(PAF(2),VFR(2),o[0],0,0,0), C1,0); \
    KRD(GL,3); GAPB(o[1]=__builtin_amdgcn_mfma_f32_32x32x16_bf16(PAF(2),VFR(6),o[1],0,0,0), C1,4); \
    GAPB(o[0]=__builtin_amdgcn_mfma_f32_32x32x16_bf16(PAF(3),VFR(3),o[0],0,0,0), C1,8); \
    GAPB(o[1]=__builtin_amdgcn_mfma_f32_32x32x16_bf16(PAF(3),VFR(7),o[1],0,0,0), C1,12); \
    }while(0)
  int t=1;
  #undef CMASK
  #define CMASK(P0,P1,t) do{}while(0)
  for(;t+5<NT;t+=2){
    STEP(pB0,pB1,pA0,pA1,t,true,true,true);     WAIT_BAR(2); RESC(); ROT();
    STEP(pA0,pA1,pB0,pB1,t+1,true,true,true);   WAIT_BAR(2); RESC(); ROT();
  }
  #undef CMASK
  #define CMASK(P0,P1,t) do{int jb_=(t)-(NT-4); if(jb_>=0)cmask(P0,P1,jb_,qrel,hi);}while(0)
  #define ENDW(tt) do{ if((tt)+3<NT){WAIT_BAR(2);} else if((tt)+2<NT){WAIT_BAR(1);} else {WAIT_BAR(0);} }while(0)
  for(;t+1<NT;t+=2){
    STEP(pB0,pB1,pA0,pA1,t,(t+3<NT),(t+1<NT),(t+1<NT));       ENDW(t);   RESC(); ROT();
    STEP(pA0,pA1,pB0,pB1,t+1,(t+4<NT),(t+2<NT),(t+2<NT));     ENDW(t+1); RESC(); ROT();
  }
  STEP(pB0,pB1,pA0,pA1,NT-1,false,false,false); RESC();
  { float sacc=pB0[0]+pB0[1]; _Pragma("unroll") for(int r=2;r<16;++r)sacc+=pB0[r]; _Pragma("unroll") for(int r=0;r<16;++r)sacc+=pB1[r]; l_reg+=sacc;
    pw0=(u32x4){PKW(pB0,0),PKW(pB0,2),PKW(pB0,4),PKW(pB0,6)};pw1=(u32x4){PKW(pB0,8),PKW(pB0,10),PKW(pB0,12),PKW(pB0,14)};pw2=(u32x4){PKW(pB1,0),PKW(pB1,2),PKW(pB1,4),PKW(pB1,6)};pw3=(u32x4){PKW(pB1,8),PKW(pB1,10),PKW(pB1,12),PKW(pB1,14)};
    SBAR(); pv(o,vb0+sl_cur,PAF(0),PAF(1),PAF(2),PAF(3)); }
  #undef PKW
  #undef PAF
  #undef VFR
  #undef PIN
  #undef MX3
  #undef GAPA
  #undef GAPB
  #undef EX
  #undef VRD
  #undef KRD
  #undef STEP
  #undef ENDW
  {auto rr=__builtin_amdgcn_permlane32_swap(__float_as_uint(l_reg),__float_as_uint(l_reg),false,false);l_reg=__uint_as_float(rr[0])+__uint_as_float(rr[1]);}
  if(hi==0)wsf[32+r32]=l_reg;asm volatile("s_waitcnt lgkmcnt(0)":::"memory");
  float rli[16];
  #pragma unroll
  for(int r=0;r<16;++r)rli[r]=__builtin_amdgcn_rcpf(wsf[32+crow(r,hi)]);
  bf16*Ow=O+(rowbase+q0+wid*QBLK)*DMO+h*D;
  { bf16*stg=(bf16*)(shm+LDS_OST)+wid*2048;
    #pragma unroll
    for(int r=0;r<16;++r){const int orow=crow(r,hi);
      #pragma unroll
      for(int d0=0;d0<2;++d0)stg[orow*64+d0*32+r32]=__float2bfloat16(o[d0][r]*rli[r]);}
    asm volatile("s_waitcnt lgkmcnt(0)":::"memory");
    #pragma unroll
    for(int i=0;i<4;++i){const int row=i*8+(lane>>3),ch=lane&7; const u32x4 v=*(const u32x4*)(stg+row*64+ch*8); ATTN_STORE16(Ow+(long)row*DMO+ch*8,v);} }
  asm volatile("s_waitcnt lgkmcnt(0)\n\ts_barrier":::"memory");
  #undef DMA_K
  #undef DMA_V
  #undef CMASK
  #undef BIAS
  #undef START
  #undef RESC
  #undef ROT
}
constexpr int ATTN_LDS_BYTES=LDS_BYTES;
#undef SBAR
#undef WAIT_BAR
}
#define XB_TMO      128
#define XB_XCNT(j)  (256  + 64 * (j))
#define XB_XSUB(j)  (1280 + 64 * (j))
#define XB_XGEN(j)  (2304 + 64 * (j))
#define XB_TOP      3328
#define XB_TOPGEN   3392
#define XCD_BAR_WORDS 3456
#define XB_SPIN_CAP (1u << 18)

__device__ __forceinline__ unsigned xb_ld(unsigned* p)              { return __hip_atomic_load(p, __ATOMIC_RELAXED, __HIP_MEMORY_SCOPE_AGENT); }
__device__ __forceinline__ unsigned xb_add(unsigned* p, unsigned v) { return __hip_atomic_fetch_add(p, v, __ATOMIC_RELAXED, __HIP_MEMORY_SCOPE_AGENT); }
__device__ __forceinline__ unsigned xb_xcc_id() { return (unsigned)__builtin_amdgcn_s_getreg((3 << 11) | 20) & 0xFu; }
#define XB_SPIN(cond, bar) do { unsigned _sp = 0; while (cond) { __builtin_amdgcn_s_sleep(1); \
    if ((++_sp & 255u) == 0u) { if (xb_ld(&(bar)[XB_TMO])) break; if (_sp > XB_SPIN_CAP) { atomicAdd(&(bar)[XB_TMO], 1u); break; } } } } while (0)

struct XcdBarrier {
    unsigned* bar; unsigned x;
    volatile LAS unsigned* st;
};

__device__ __forceinline__ XcdBarrier xcd_barrier_post(unsigned* bar, volatile LAS unsigned* st) {
    XcdBarrier b; b.bar = bar; b.x = xb_xcc_id(); b.st = st;
    if (threadIdx.x == 0) (void)xb_add(&bar[XB_XCNT(b.x)], 1u);
    return b;
}
__device__ __forceinline__ void xcd_barrier_complete(unsigned* bar, unsigned x, unsigned& nloc, unsigned& nx) {
    const unsigned G = gridDim.x * gridDim.y * gridDim.z;
    unsigned sum, cnt, mine, sp = 0u;
    for (;;) {
        sum = 0u; cnt = 0u; mine = 0u;
#pragma unroll
        for (unsigned j = 0; j < 16; ++j) { const unsigned c = xb_ld(&bar[XB_XCNT(j)]); sum += c; cnt += (c > 0u) ? 1u : 0u; mine = (j == x) ? c : mine; }
        if (sum == G) break;
        __builtin_amdgcn_s_sleep(1);
        if ((++sp & 255u) == 0u) { if (xb_ld(&bar[XB_TMO])) break; if (sp > XB_SPIN_CAP) { atomicAdd(&bar[XB_TMO], 1u); break; } }
    }
    nloc = mine > 0u ? mine : 1u; nx = cnt > 0u ? cnt : 1u;
}

__device__ __forceinline__ void xcd_barrier(const XcdBarrier& b) {
    asm volatile("s_waitcnt vmcnt(0)" ::: "memory");
    __syncthreads();
    if (threadIdx.x == 0) {
        unsigned* bar = b.bar;
        __builtin_amdgcn_s_waitcnt(0);
        unsigned nloc = b.st[0], nx = b.st[1];
        if (nloc == 0u) { xcd_barrier_complete(bar, b.x, nloc, nx); b.st[0] = nloc; b.st[1] = nx; }
        const unsigned old = xb_add(&bar[XB_XSUB(b.x)], 1u);
        const unsigned gen = old / nloc;
        if (old + 1u == (gen + 1u) * nloc) {
            __builtin_amdgcn_fence(__ATOMIC_RELEASE, "agent");
            asm volatile("s_waitcnt vmcnt(0)" ::: "memory");
            const unsigned og = xb_add(&bar[XB_TOP], 1u);
            const unsigned tg = og / nx;
            if (og + 1u == (tg + 1u) * nx) xb_add(&bar[XB_TOPGEN], 1u);
            else XB_SPIN(xb_ld(&bar[XB_TOPGEN]) == tg, bar);
            __builtin_amdgcn_fence(__ATOMIC_ACQUIRE, "agent");
            xb_add(&bar[XB_XGEN(b.x)], 1u);
            asm volatile("s_waitcnt vmcnt(0)" ::: "memory");
        } else {
            XB_SPIN(xb_ld(&bar[XB_XGEN(b.x)]) == gen, bar);
            __builtin_amdgcn_fence(__ATOMIC_ACQUIRE, "agent");
            asm volatile("s_waitcnt vmcnt(0)" ::: "memory");
        }
    }
    __syncthreads();
}
struct Args { const float* in[21]; float* out; unsigned char* ws; int ph_lo, ph_hi; };
enum { I_X = 0, I_MEM, I_REL, I_MEMNORM, I_NORMF, I_NORMMIX, I_WIN, I_FBIAS, I_GW2, I_GB, I_CNORM, I_WOUT, I_NORMCROSS, I_WCQ, I_WCKV, I_WCO, I_NORMFFN, I_WUP, I_CONVW, I_CONVB, I_WDOWN };
#ifndef PROBE_PH
#define PROBE_PH -1
#endif
#ifndef PROBE_SUB
#define PROBE_SUB 0
#endif
constexpr int LDS_BARW = 149504;
constexpr size_t WS_QG = 938 * MiB, WS_KG = 962 * MiB, WS_END2 = 986 * MiB;
constexpr size_t WS_TOT = WS_DEC + 900 * 1024, WS_OFFS = WS_TOT + 8192, WS_NRM = WS_OFFS + 8192;
constexpr size_t WS_SS = 986 * MiB, SS_BYTES = 2 * MiB;
constexpr int PH_PER_LAYER = 12, N_PHASES = PH_PER_LAYER * DEPTH + 1;

constexpr int WT_IA = 32 * 200, WT_IB = 32 * 64, WT_IC = 32 * 16, WT_ID = 32 * 32, WT_IE = 8 * 64, WT_IF = 32 * 344, WT_IG = 86 * 64;
constexpr int WT_EARLY = WT_IA + WT_IB + WT_IC + WT_ID + WT_IE, WT_NIT = WT_EARLY + WT_IF + WT_IG;
#define WT_FIRST5(r_, ll) do { int q_ = (r_); \
        if (q_ < WT_IA) { wt_item<1>(ap->in[I_WIN] + (size_t)(ll) * D * PROJW, D, PROJW, Win, scr, q_, 200, 1.f, ap->in[I_NORMMIX] + (size_t)(ll) * D, lane); break; } q_ -= WT_IA; \
        if (q_ < WT_IB) { wt_item<0>(ap->in[I_WOUT] + (size_t)(ll) * D * D, D, D, Wout, scr, q_, 64, 1.f, nullptr, lane); break; } q_ -= WT_IB; \
        if (q_ < WT_IC) { wt_item<0>(ap->in[I_WCQ] + (size_t)(ll) * D * CW, D, CW, Wcq, scr, q_, 16, 0.08838834764831845f * LOG2E, ap->in[I_NORMCROSS] + (size_t)(ll) * D, lane); break; } q_ -= WT_IC; \
        if (q_ < WT_ID) { wt_item<0>(ap->in[I_WCKV] + (size_t)(ll) * D * 2 * CW, D, 2 * CW, Wckv, scr, q_, 32, 1.f, nullptr, lane); break; } q_ -= WT_ID; \
        wt_item<0>(ap->in[I_WCO] + (size_t)(ll) * CW * D, CW, D, Wco, scr, q_, 64, 1.f, nullptr, lane); } while (0)

__global__ void __launch_bounds__(NTHR, 2) fwd_mega(Args args) {
    extern __shared__ __attribute__((aligned(16))) unsigned char lds_raw[];
    LAS char* lds = (LAS char*)lds_raw;
    cg::grid_group grid = cg::this_grid();
    const int G0 = gridDim.x, bx0 = blockIdx.x;
    const int vcu0 = (G0 % 8 == 0) ? (bx0 % 8) * (G0 / 8) + bx0 / 8 : bx0;
    typedef const __attribute__((address_space(4))) Args* KArgs;
    KArgs ap = (KArgs)__builtin_amdgcn_kernarg_segment_ptr();
    const int ph_lo = args.ph_lo, ph_hi = args.ph_hi;
    if (threadIdx.x < 2) ((LAS unsigned*)(lds + LDS_BARW))[threadIdx.x] = 0u;
    __syncthreads();
    XcdBarrier bar = xcd_barrier_post((unsigned*)(args.ws + WS_CTL) + 4096, (volatile LAS unsigned*)(lds + LDS_BARW));
    int probe_done = 0, in_rep = 0;
    for (int ph = ph_lo; ph < ph_hi; ++ph) {
        const int tid = otid(), lane = tid & 63; const int wave = __builtin_amdgcn_readfirstlane(tid >> 6);
        int G = G0, bx = bx0, vcu = vcu0; asm volatile("" : "+s"(G), "+s"(bx), "+s"(vcu));
        asm volatile("" : "+s"(ap));
        const int gw = vcu * NWAVES + wave, NGW = G * NWAVES;
        unsigned char* ws = ap->ws;
        bf16* Win = (bf16*)(ws + WS_WIN); bf16* Wout = (bf16*)(ws + WS_WOUT); bf16* Wcq = (bf16*)(ws + WS_WCQ); bf16* Wckv = (bf16*)(ws + WS_WCKV);
        bf16* Wco = (bf16*)(ws + WS_WCO); bf16* Wup = (bf16*)(ws + WS_WUP); bf16* Wdown = (bf16*)(ws + WS_WDOWN);
        bf16* XN = (bf16*)(ws + WS_XN); bf16* OA = (bf16*)ap->out;     bf16* PROJ = (bf16*)(ws + WS_PROJ); bf16* QKVA = (bf16*)(ws + WS_QKVA); bf16* ACT = (bf16*)(ws + WS_ACT);
        bf16* QC = (bf16*)(ws + WS_QC); bf16* OC = (bf16*)(ws + WS_OC); bf16* MIXED = (bf16*)(ws + WS_MIXED); bf16* MEMN = (bf16*)(ws + WS_MEMN); bf16* KVC = (bf16*)(ws + WS_KVC);
        bf16* SC = (bf16*)(ws + WS_SC); float* DEC = (float*)(ws + WS_DEC); float* C2 = (float*)(ws + WS_C2); float* LSE = (float*)(ws + WS_LSE);
        float* GLb = (float*)(ws + WS_GL); float* GFb = (float*)(ws + WS_GF); float* VFb = (float*)(ws + WS_VF);
        unsigned long long* SSB = (unsigned long long*)(ws + WS_SS);
        bf16* QG = (bf16*)(ws + WS_QG); bf16* KG = (bf16*)(ws + WS_KG); float* TOTB = (float*)(ws + WS_TOT); float* OFFS = (float*)(ws + WS_OFFS); float* NRM = (float*)(ws + WS_NRM);
        const int l = ph / PH_PER_LAYER, k = (ph == N_PHASES - 1) ? 99 : ph % PH_PER_LAYER;
        switch (k) {
        case 0: {
            LAS float* scr = (LAS float*)(lds + wave * 16384);
            const float* wup = ap->in[I_WUP] + (size_t)l * D * 2 * DFF; const float* wdown = ap->in[I_WDOWN] + (size_t)l * DFF * D;
            for (int it = ((l > 0 && G == 256) ? WT_EARLY : 0) + gw; it < WT_NIT; it += NGW) {
                int r = it;
                if (r < WT_EARLY) { WT_FIRST5(r, l); continue; } r -= WT_EARLY;
                if (r < WT_IF) { wt_item<2>(wup, D, 2 * DFF, Wup, scr, r, 344, 1.f, ap->in[I_NORMFFN] + (size_t)l * D, lane); continue; } r -= WT_IF;
                wt_item<0>(wdown, DFF, D, Wdown, scr, r, 64, 1.f, nullptr, lane);
            }
            if (l == 0) {
                for (int m = gw; m < T; m += NGW) xconv_row(ap->in[I_X] + (size_t)m * D, XN + (size_t)m * D, SSB + m, lane);
                for (int m = gw; m < BATCH * MEMLEN; m += NGW) norm_row_bf16(ap->in[I_MEM] + (size_t)m * D, ap->in[I_MEMNORM], MEMN + (size_t)m * D, lane);
            }
        } break;
        case 1: {
            { pg8::Gemm g{XN, Win, T, PROJN, D}; pg8::StaticOrder S; S.init(T, PROJN, G, bx); pg8::EpiBf16 E{QKVA, QAP, PROJ, PROJP, QAP / 256, SSB + (size_t)(3 * l) * T};
              pg8::gemm_phase<pg8::EpiBf16, pg8::StaticOrder, true, true>((LAS unsigned char*)lds, g, S, E); }
            { pg8::Gemm g{MEMN, Wckv, BATCH * MEMLEN, 2 * CW, D}; pg8::StaticOrder S; S.init(BATCH * MEMLEN, 2 * CW, G, (bx + G - G / 2) % G); pg8::EpiBf16 E{KVC, 2 * CW, nullptr, 0, 0, nullptr};
              pg8::gemm_phase<pg8::EpiBf16, pg8::StaticOrder, true, true>((LAS unsigned char*)lds, g, S, E); }
        } break;
        case 2: {
            for (int c = vcu; c < T / 128; c += G) fscan_chunk(lds, c, PROJ, ap->in[I_FBIAS] + l * 8, C2, TOTB);
            if (!(in_rep && PROBE_SUB == 1)) for (int j_ = vcu; j_ < 2048; j_ += G) gla_unit<1>(lds, ((j_ >> 9) * 4 + (j_ & 3)) * 128 + ((j_ >> 2) & 127), PROJ,     ap->in[I_GW2] + (size_t)l * 16 * 384, ap->in[I_GB] + l * 384, SC, DEC, nullptr, nullptr, QG, KG);
            if (!(in_rep && PROBE_SUB == 2)) {
                DilRegs RG = {}; DilU cur = {}, nxt = {}; int it = 0;
#define DIL_MAKE(A, uu) do { const int p_ = (uu) / 1536, rem_ = (uu) - 1536 * p_, bc_ = rem_ / 12, h_ = rem_ - 12 * bc_, b_ = bc_ >> 5, cb_ = bc_ & 31;     \
                const int r_ = (p_ == 0) ? 1 : (p_ == 1 ? 4 : 16), nbk_ = 32 / r_, c_ = cb_ / nbk_, n_ = cb_ - nbk_ * c_; \
                const size_t qrow_ = (size_t)b_ * SEQ + c_ + (size_t)r_ * 256 * n_; const long krow_ = (long)b_ * SEQ + c_ + (long)r_ * (256 * n_ - 128); \
                (A).Qb = QKVA + qrow_ * QAP + O_QA + 64 * h_; (A).qstride = r_ * QAP; \
                (A).Kb = QKVA + krow_ * QAP + O_KA + 64 * h_; (A).kstride = r_ * QAP; (A).row_lo = (n_ == 0) ? 128 : 0; \
                (A).Ob = OA + (size_t)p_ * T * 768 + qrow_ * 768 + 64 * h_; (A).ostride = r_ * 768; \
                (A).lse = LSE + (size_t)p_ * T * 12 + qrow_ * 12 + h_; (A).lstride = r_ * 12; } while (0)
#define DIL_TBLP(uu) ((const LAS float*)(lds + DIL_TBLS) + (((uu) / 1536) * 12 + ((uu) % 1536) % 12) * 192)
                for (int e = tid; e < 36 * 192; e += NTHR) { const int tb_ = e / 192, st_ = e - 192 * tb_ - 32, p_ = tb_ / 12, h_ = tb_ - 12 * p_, r_ = (p_ == 0) ? 1 : (p_ == 1 ? 4 : 16); float tv = -INFINITY;
                    if (st_ >= 0 && st_ <= 128) { const int dist = st_ * r_; int bk;
                        if (dist < 16) bk = dist; else { bk = 16 + (int)(logf((float)dist * (1.f / 16.f)) / logf(128.f) * 16.f); bk = bk > 31 ? 31 : bk; }
                        tv = ap->in[I_REL][bk * 12 + h_] * LOG2E; }
                    ((LAS float*)(lds + DIL_TBLS))[e] = tv; }
                if (vcu < 4608) { DIL_MAKE(cur, vcu); DIL_GLOAD(cur, RG); }
                for (int u = vcu; u < 4608; u += G) {
                    const bool has_next = (u + G < 4608);
                    DIL_LWRITE(RG);
                    bf16x8 qf[4];
#pragma unroll
                    for (int d0 = 0; d0 < 4; ++d0) qf[d0] = RG.q[d0];
                    __syncthreads();
                    if (has_next) { DIL_MAKE(nxt, u + G); DIL_GLOAD(nxt, RG); }
                    dil_compute(lds, cur, DIL_TBLP(u), tid, qf);
                    asm volatile("s_waitcnt lgkmcnt(0)\n\ts_barrier" ::: "memory");
                    cur = nxt; ++it;
                }
#undef DIL_MAKE
#undef DIL_TBLP
            }
        } break;
        case 3: {
            if (vcu == G - 1 && tid < 32) { const int b_ = tid >> 3, h_ = tid & 7; float acc = 0.f;
                for (int cc = 0; cc < 64; ++cc) { OFFS[(b_ * 64 + cc) * 8 + h_] = acc; acc += TOTB[(b_ * 64 + cc) * 8 + h_]; } }
            {
                for (int it = gw; it < 2 * 4096; it += NGW) { const int isk = it >= 4096, tt = it & 4095, bh_ = tt >> 7, t64 = tt & 127;
                    const bf16* rp = PROJ + ((size_t)(bh_ >> 3) * SEQ + 64 * t64 + lane) * PROJP + (isk ? O_KB : O_QB) + 64 * (bh_ & 7);
                    float s2 = 0.f;
#pragma unroll
                    for (int c8 = 0; c8 < 8; ++c8) { const u32x4 v = *(const u32x4*)(rp + 8 * c8);
#pragma unroll
                        for (int q = 0; q < 4; ++q) { const float a0 = bflo(v[q]), a1 = bfhi(v[q]); s2 += a0 * a0 + a1 * a1; } }
#pragma unroll
                    for (int o = 1; o < 64; o <<= 1) s2 = fmaxf(s2, __shfl_xor(s2, o));
                    if (lane == 0) NRM[it] = sqrtf(s2); }
            }
            {
                if (tid < 288) for (int pb = vcu * 576; pb < 16 * 9216; pb += G * 576) {
                    unsigned* sp[2]; const float* dp[2]; float st[2][2]; bool ok[2];
#pragma unroll
                    for (int q = 0; q < 2; ++q) { const int pe = pb + tid + 288 * q; ok[q] = pe < 16 * 9216; const int pp = ok[q] ? pe : 0; const int bh = pp / 9216, vk = pp - 9216 * bh, k0 = 2 * (vk % 48);
                        sp[q] = (unsigned*)SC + (size_t)bh * 128 * 9216 + vk; dp[q] = DEC + (size_t)bh * 128 * 96 + k0; st[q][0] = 0.f; st[q][1] = 0.f; }
                    for (int n = 0; n < 128; n += 8) { unsigned tv[2][8]; float d0[2][8], d1[2][8];
#pragma unroll
                        for (int q = 0; q < 2; ++q)
#pragma unroll
                            for (int jj = 0; jj < 8; ++jj) { tv[q][jj] = sp[q][(size_t)(n + jj) * 9216]; d0[q][jj] = dp[q][(n + jj) * 96]; d1[q][jj] = dp[q][(n + jj) * 96 + 1]; }
#pragma unroll
                        for (int q = 0; q < 2; ++q) if (ok[q]) {
#pragma unroll
                            for (int jj = 0; jj < 8; ++jj) { sp[q][(size_t)(n + jj) * 9216] = pk2(st[q][0], st[q][1]);
                                st[q][0] = st[q][0] * d0[q][jj] + bflo(tv[q][jj]); st[q][1] = st[q][1] * d1[q][jj] + bfhi(tv[q][jj]); } } } }
            }
            {
                const int gt = vcu * NTHR + tid, NGT = G * NTHR;
                for (int e0 = gt; e0 < T * 96; e0 += 4 * NGT) {
                    float ls[4][3]; u32x4 ov[4][3]; int tt[4], cc[4]; bool ok[4];
#pragma unroll
                    for (int q = 0; q < 4; ++q) { const int e = e0 + q * NGT; ok[q] = e < T * 96; const int ee = ok[q] ? e : e0; const int t = ee / 96, rem = ee - 96 * t, h = rem >> 3, ch = rem & 7; tt[q] = t; cc[q] = 64 * h + 8 * ch;
#pragma unroll
                        for (int pp = 0; pp < 3; ++pp) { ls[q][pp] = LSE[(size_t)pp * T * 12 + (size_t)t * 12 + h]; ov[q][pp] = *(const u32x4*)(OA + (size_t)pp * T * 768 + (size_t)t * 768 + cc[q]); } }
#pragma unroll
                    for (int q = 0; q < 4; ++q) if (ok[q]) {
                        const float mx = fmaxf(fmaxf(ls[q][0], ls[q][1]), ls[q][2]);
                        float wsum = 0.f, acc[8];
#pragma unroll
                        for (int jj = 0; jj < 8; ++jj) acc[jj] = 0.f;
#pragma unroll
                        for (int pp = 0; pp < 3; ++pp) { const float wp = __builtin_amdgcn_exp2f(ls[q][pp] - mx); wsum += wp;
#pragma unroll
                            for (int x = 0; x < 4; ++x) { acc[2 * x] += wp * bflo(ov[q][pp][x]); acc[2 * x + 1] += wp * bfhi(ov[q][pp][x]); } }
                        const float inv = 1.f / wsum; u32x4 o;
#pragma unroll
                        for (int x = 0; x < 4; ++x) o[x] = pk2(acc[2 * x] * inv, acc[2 * x + 1] * inv);
                        *(u32x4*)(MIXED + (size_t)tt[q] * D + cc[q]) = o; } }
            }
        } break;
        case 4: {
            if (!(in_rep && PROBE_SUB == 1)) for (int j_ = vcu; j_ < 2048; j_ += G) gla_unit<3>(lds, ((j_ >> 9) * 4 + (j_ & 3)) * 128 + ((j_ >> 2) & 127), PROJ, ap->in[I_GW2] + (size_t)l * 16 * 384, ap->in[I_GB] + l * 384, SC, DEC, ap->in[I_CNORM] + l * 192, MIXED, QG, KG);
            if (!(in_rep && PROBE_SUB == 2)) {
                static_assert(attn_body::ATTN_LDS_BYTES <= LDS_BARW, "attention LDS");
                for (int i = 0; i < 4; ++i) {
                    int bh, qb;
                    if (G == 256) { const int s = vcu & 7; bh = vcu >> 3; qb = (i == 0) ? s : (i == 1) ? 15 - s : (i == 2) ? 16 + s : 31 - s; }
                    else { const int u = vcu + i * G; if (u >= 1024) break; bh = u >> 5; qb = u & 31; }
                    int ts = 0;
                    { const int NTf = 4 * (qb + 1); const float* cg = C2 + (size_t)bh * SEQ; const float* og = OFFS + (size_t)(bh >> 3) * 64 * 8 + (bh & 7);
                      const float* qn = NRM + bh * 128 + 4 * qb; const float* kn = NRM + 4096 + bh * 128;
                      const float Qn = fmaxf(fmaxf(qn[0], qn[1]), fmaxf(qn[2], qn[3])) * 1.01f;
                      const int t0_ = lane, t1_ = lane + 64;
                      const float k0_ = (t0_ < NTf) ? kn[t0_] : 0.f, k1_ = (t1_ < NTf) ? kn[t1_] : 0.f;
                      float kmax = fmaxf(k0_, k1_);
#pragma unroll
                      for (int o = 1; o < 64; o <<= 1) kmax = fmaxf(kmax, __shfl_xor(kmax, o));
                      kmax *= 1.01f;
                      const int q0_ = 256 * qb; const float Cq = cg[q0_] + og[(q0_ >> 7) * 8];
                      const float thr = -Qn * kmax - 150.f;
                      bool keep0 = true, keep1 = true;
                      if (t0_ < NTf) { const int e = 64 * t0_ + 63; keep0 = !(Qn * k0_ * 1.01f + (Cq - (cg[e] + og[(e >> 7) * 8])) < thr); }
                      if (t1_ < NTf) { const int e = 64 * t1_ + 63; keep1 = !(Qn * k1_ * 1.01f + (Cq - (cg[e] + og[(e >> 7) * 8])) < thr); }
                      const unsigned long long b0 = __ballot(keep0), b1 = __ballot(keep1);
                      const int first = b0 ? __builtin_ctzll(b0) : 64 + (b1 ? __builtin_ctzll(b1) : 0);
                      ts = first & ~1; if (ts > NTf - 4) ts = NTf - 4; if (ts < 0) ts = 0;
                      ts = __builtin_amdgcn_readfirstlane(ts); }
                    attn_body::attn_unit<40>(bh >> 3, bh & 7, qb, (const attn_body::bf16*)(PROJ + O_QB), (const attn_body::bf16*)(PROJ + O_KB), (const attn_body::bf16*)(PROJ + O_VB),
                                            (attn_body::bf16*)(MIXED + 768), C2 + (size_t)bh * SEQ, OFFS + (size_t)(bh >> 3) * 64 * 8 + (bh & 7), ts, (char*)lds_raw);
                }
            }
        } break;
        case 5: case 8: case 11: {
            pg8::Gemm g; if (k == 5) g = pg8::Gemm{MIXED, Wout, T, D, D}; else if (k == 8) g = pg8::Gemm{OC, Wco, T, D, CW}; else g = pg8::Gemm{ACT, Wdown, T, D, DFF};
            unsigned long long* ssn = SSB + (size_t)(k == 5 ? 3 * l + 1 : (k == 8 ? 3 * l + 2 : 3 * l + 3)) * T;
            pg8::StaticOrder S; S.init(T, D, G, bx); pg8::EpiRes E{XN, D, (k == 11 && l == DEPTH - 1) ? nullptr : ssn};
            pg8::gemm_phase<pg8::EpiRes, pg8::StaticOrder, true, true>((LAS unsigned char*)lds, g, S, E);
        } break;
        case 6: {
            pg8::Gemm g{XN, Wcq, T, CW, D}; pg8::StaticOrder S; S.init(T, CW, G, bx); pg8::EpiBf16 E{QC, CW, nullptr, 0, 0, SSB + (size_t)(3 * l + 1) * T};
            pg8::gemm_phase<pg8::EpiBf16, pg8::StaticOrder, true, true>((LAS unsigned char*)lds, g, S, E);
        } break;
        case 7: {
            for (int u = vcu; u < 512; u += G) { const int b = u >> 7, qb = (u >> 2) & 31, h = u & 3;     const size_t qrow = (size_t)b * SEQ + 256 * qb;
                AttnU a;
                a.Qb = QC + qrow * CW + 128 * h; a.qstride = CW;
                a.Kb = KVC + (size_t)b * MEMLEN * 2 * CW + 128 * h; a.Vb = a.Kb + CW; a.kstride = 2 * CW;
                a.Ob = OC + qrow * CW + 128 * h; a.ostride = CW;
                a.NT = 4; a.t_begin = 0; a.cq = nullptr; a.ck = nullptr; a.q0 = 0; a.lse = nullptr; a.lstride = 0;
                attn_unit<128, 0>(lds, a, nullptr); }
        } break;
        case 9: {
            pg8::Gemm g{XN, Wup, T, 2 * DFF, D}; pg8::StaticOrder S; S.init(T, 2 * DFF, G, bx);
            pg8::EpiConv E{ACT, ap->in[I_CONVW] + (size_t)l * 3 * DFF, ap->in[I_CONVB] + (size_t)l * DFF, GLb, GFb, VFb, SSB + (size_t)(3 * l + 2) * T};
            pg8::gemm_phase<pg8::EpiConv, pg8::StaticOrder, true, true>((LAS unsigned char*)lds, g, S, E);
            if (l + 1 < DEPTH && G == 256 && bx >= 128) {
                LAS float* scr = (LAS float*)(lds + wave * 16384);
                for (int it = (bx - 128) * NWAVES + wave; it < WT_EARLY; it += 128 * NWAVES) WT_FIRST5(it, l + 1);
            }
        } break;
        case 10: {
            const float* cw = ap->in[I_CONVW] + (size_t)l * 3 * DFF; const float* cb = ap->in[I_CONVB] + (size_t)l * DFF;
            const int gt = vcu * NTHR + tid, NGT = G * NTHR;
            for (int e = gt; e < 512 * 1376; e += NGT) { const int sl = e / 1376, c4 = (e - 1376 * sl) * 4;
                f32x4 gm2 = (f32x4){0.f, 0.f, 0.f, 0.f}, gm1 = gm2;
                if (sl % 128 != 0) { gm2 = *(const f32x4*)(GLb + (size_t)((sl - 1) * 2) * DFF + c4); gm1 = *(const f32x4*)(GLb + (size_t)((sl - 1) * 2 + 1) * DFF + c4); }
                const f32x4 g0 = *(const f32x4*)(GFb + (size_t)(sl * 2) * DFF + c4), g1 = *(const f32x4*)(GFb + (size_t)(sl * 2 + 1) * DFF + c4);
                const f32x4 v0 = *(const f32x4*)(VFb + (size_t)(sl * 2) * DFF + c4), v1 = *(const f32x4*)(VFb + (size_t)(sl * 2 + 1) * DFF + c4);
                const f32x4 w0 = *(const f32x4*)(cw + c4), w1 = *(const f32x4*)(cw + DFF + c4), w2 = *(const f32x4*)(cw + 2 * DFF + c4), b4 = *(const f32x4*)(cb + c4);
                const f32x4 a0 = b4 + w0 * gm2 + w1 * gm1 + w2 * g0, a1 = b4 + w0 * gm1 + w1 * g0 + w2 * g1;
                float y0[4], y1[4];
#pragma unroll
                for (int q = 0; q < 4; ++q) { y0[q] = a0[q] / (1.f + __expf(-a0[q])) * v0[q]; y1[q] = a1[q] / (1.f + __expf(-a1[q])) * v1[q]; }
                u32x2 o0, o1; o0.x = pk2(y0[0], y0[1]); o0.y = pk2(y0[2], y0[3]); o1.x = pk2(y1[0], y1[1]); o1.y = pk2(y1[2], y1[3]);
                *(u32x2*)(ACT + (size_t)(64 * sl) * DFF + c4) = o0; *(u32x2*)(ACT + (size_t)(64 * sl + 1) * DFF + c4) = o1; }
        } break;
        default: {
            for (int m = gw; m < T; m += NGW) norm_row_out(XN + (size_t)m * D, ap->in[I_NORMF], ap->out + (size_t)m * D, lane);
        } break;
        }
        if (ph == PROBE_PH && !probe_done) { probe_done = 1; in_rep = 1; xcd_barrier(bar); --ph; continue; }
        in_rep = 0;
        if (ph + 1 < ph_hi) { if (ph == ph_lo) grid.sync(); else xcd_barrier(bar); }
    }
}

#ifndef N_LAUNCH_MODE
#define N_LAUNCH_MODE 1
#endif
extern "C" void kernel_launch(void* const* d_in, const int* in_sizes, int n_in, void* d_out, int out_size, void* d_ws, size_t ws_size, hipStream_t stream) {
    static int grid = 0;
    if (grid == 0) {
        if (n_in != 21 || out_size != T * D || ws_size < WS_SS + SS_BYTES) { fprintf(stderr, "kernel_launch: unexpected problem (n_in %d out %d ws %zu)\n", n_in, out_size, ws_size); grid = -1; return; }
        int dev = 0, cus = 0, per_cu = 0;
        hipGetDevice(&dev); hipDeviceGetAttribute(&cus, hipDeviceAttributeMultiprocessorCount, dev);
        if (hipFuncSetAttribute((const void*)fwd_mega, hipFuncAttributeMaxDynamicSharedMemorySize, LDS_BYTES) != hipSuccess) { fprintf(stderr, "kernel_launch: hipFuncSetAttribute failed\n"); grid = -1; return; }
        hipOccupancyMaxActiveBlocksPerMultiprocessor(&per_cu, (const void*)fwd_mega, NTHR, LDS_BYTES);
        (void)hipGetLastError();
        if (per_cu < 1) { fprintf(stderr, "kernel_launch: occupancy query says %d blocks per CU\n", per_cu); per_cu = 1; }
        grid = cus;
    }
    if (grid < 0) return;
    if (hipMemsetAsync((char*)d_ws + WS_CTL, 0, 1u << 20, stream) != hipSuccess) { fprintf(stderr, "kernel_launch: memset failed\n"); return; }
    if (hipMemsetAsync((char*)d_ws + WS_SS, 0, SS_BYTES, stream) != hipSuccess) { fprintf(stderr, "kernel_launch: memset failed\n"); return; }
    Args a{};
    for (int i = 0; i < 21; ++i) a.in[i] = (const float*)d_in[i];
    a.out = (float*)d_out; a.ws = (unsigned char*)d_ws;
#if N_LAUNCH_MODE == 1
    a.ph_lo = 0; a.ph_hi = N_PHASES;
    void* kargs[] = {&a};
    hipError_t e = hipLaunchCooperativeKernel((const void*)fwd_mega, dim3(grid), dim3(NTHR), kargs, LDS_BYTES, stream);
    if (e != hipSuccess) fprintf(stderr, "kernel_launch: cooperative launch failed: %s (grid %d)\n", hipGetErrorString(e), grid);
#else
    for (int ph = 0; ph < N_PHASES; ++ph) { a.ph_lo = ph; a.ph_hi = ph + 1; hipLaunchKernelGGL(fwd_mega, dim3(grid), dim3(NTHR), LDS_BYTES, stream, a); }
#endif
}
```

```cpp
#include <hip/hip_runtime.h>
#include <hip/hip_cooperative_groups.h>
#include <cstdio>
#include <cstdint>
#include <cmath>
namespace cg = cooperative_groups;
__device__ __forceinline__ int otid() { int t = threadIdx.x; asm volatile("" : "+v"(t)); return t; }
namespace pg8 {
#define PG8_LAS __attribute__((address_space(3)))
typedef unsigned short bf16_t;
typedef short bf16x8 __attribute__((ext_vector_type(8)));
typedef float f32x4 __attribute__((ext_vector_type(4)));
typedef unsigned u32x4 __attribute__((ext_vector_type(4)));
constexpr int BM = 256, BK = 64, HALF = 128, HTB = HALF * BK * 2  , STAGE_BYTES = 8 * HTB, NXCD = 8, WGM = 4;

__host__ __device__ __forceinline__ int lds_byte(int r, int c) { const int st = (r >> 4) * 2 + (c >> 5), rr = r & 15, cc = c & 31, ob = rr * 64 + cc * 2; return st * 1024 + (ob ^ (((ob >> 9) & 1) << 5)); }
__host__ __device__ __forceinline__ void stage_rc(int b, int& R, int& C) { const int st = b / 1024, sb = b % 1024, swz = sb ^ (((sb >> 9) & 1) << 5); R = (st >> 1) * 16 + swz / 64; C = (st & 1) * 32 + (swz % 64) / 2; }
__host__ __device__ __forceinline__ int perm32(int rho) { const int n = rho >> 4, i = rho & 15; return 8 * (i >> 2) + 4 * n + (i & 3); }

struct Unit { int pm, pn; };
struct Gemm { const bf16_t* A; const bf16_t* Bt; int M, N, K; };

struct StaticOrder {
    int nM, nN, nwg, G, c;
    __host__ __device__ void init(int M, int N, int G_, int c_) { nM = M / BM; nN = N / BM; nwg = nM * nN; G = G_; c = c_; }
    __host__ __device__ bool next(int i, Unit& u) const {
        const long L = (long)i * G + c; if (L >= nwg) return false;
        int wgid = (int)L; { const int q = nwg / NXCD, r = nwg % NXCD, xcd = wgid % NXCD, off = wgid / NXCD; wgid = (xcd < r ? xcd * (q + 1) : r * (q + 1) + (xcd - r) * q) + off; }
        const int nig = WGM * nN, gid = wgid / nig, fm = gid * WGM, gsz = (nM - fm) < WGM ? (nM - fm) : WGM;
        u.pm = fm + ((wgid % nig) % gsz); u.pn = (wgid % nig) / gsz; return true;
    }
    __device__ __forceinline__ void a_ready(const Unit&) const {}
    __device__ __forceinline__ void done(const Unit&) const {}
};

__device__ __forceinline__ unsigned cvt_pk_bf16(float lo, float hi) { unsigned r; asm volatile("v_cvt_pk_bf16_f32 %0, %1, %2" : "=v"(r) : "v"(lo), "v"(hi)); return r; }
typedef float f32x2 __attribute__((ext_vector_type(2)));
struct EpiBf16 {
    static constexpr bool PERM = true, AFTER_DRAIN = false;
    bf16_t* O; int ldc; bf16_t* O2; int ldc2, split;
    const unsigned long long* ss;
    __device__ __forceinline__ void operator()(const f32x4 (&acc)[2][2][4][2], const Unit& u, int wr, int wc, int fr, int fq) const {
        const int row0 = u.pm * BM + wr * 64 + fr; const bool second = split > 0 && u.pn >= split; const int col0 = (second ? u.pn - split : u.pn) * BM + wc * 32 + 8 * fq;
        bf16_t* const Ob = second ? O2 : O; const int ld = second ? ldc2 : ldc;
#pragma unroll
        for (int ai = 0; ai < 2; ++ai)
#pragma unroll
            for (int m = 0; m < 4; ++m) { bf16_t* rowp = Ob + (size_t)(row0 + ai * HALF + m * 16) * ld + col0;
                float rs = 1.f; if (ss) rs = __builtin_amdgcn_rsqf((float)ss[row0 + ai * HALF + m * 16] * (1.f / (2048.f * 262144.f)) + 1e-6f);
#pragma unroll
                for (int bj = 0; bj < 2; ++bj) { const f32x4 v0 = acc[ai][bj][m][0] * rs, v1 = acc[ai][bj][m][1] * rs;
                    u32x4 w; w.x = cvt_pk_bf16(v0[0], v0[1]); w.y = cvt_pk_bf16(v0[2], v0[3]); w.z = cvt_pk_bf16(v1[0], v1[1]); w.w = cvt_pk_bf16(v1[2], v1[3]);
                    *(u32x4*)(rowp + bj * HALF) = w; } }
    }
};
struct EpiRes {
    static constexpr bool PERM = true, AFTER_DRAIN = false;
    bf16_t* x; int ldc; unsigned long long* ss;
    __device__ __forceinline__ void operator()(const f32x4 (&acc)[2][2][4][2], const Unit& u, int wr, int wc, int fr, int fq) const {
        const int col0 = u.pn * BM + wc * 32 + 8 * fq;
#pragma unroll
        for (int ai = 0; ai < 2; ++ai)
#pragma unroll
            for (int m = 0; m < 4; ++m) { const int row = u.pm * BM + ai * HALF + wr * 64 + m * 16 + fr; bf16_t* xp = x + (size_t)row * ldc + col0;
                u32x4 bv[2];
#pragma unroll
                for (int bj = 0; bj < 2; ++bj) bv[bj] = *(const u32x4*)(xp + bj * HALF);
                float sq = 0.f;
#pragma unroll
                for (int bj = 0; bj < 2; ++bj) { u32x4 w;
#pragma unroll
                    for (int n = 0; n < 2; ++n) { const f32x4 a = acc[ai][bj][m][n]; const unsigned b0 = bv[bj][2 * n], b1 = bv[bj][2 * n + 1];
                        const float o0 = __builtin_bit_cast(float, b0 << 16) + a[0], o1 = __builtin_bit_cast(float, b0 & 0xffff0000u) + a[1];
                        const float o2 = __builtin_bit_cast(float, b1 << 16) + a[2], o3 = __builtin_bit_cast(float, b1 & 0xffff0000u) + a[3];
                        sq += (o0 * o0 + o1 * o1) + (o2 * o2 + o3 * o3);
                        w[2 * n] = cvt_pk_bf16(o0, o1); w[2 * n + 1] = cvt_pk_bf16(o2, o3); }
                    *(u32x4*)(xp + bj * HALF) = w; }
                if (ss) { sq += __shfl_xor(sq, 16); sq += __shfl_xor(sq, 32); if (fq == 0) __hip_atomic_fetch_add(ss + row, (unsigned long long)(sq * 262144.f + 0.5f), __ATOMIC_RELAXED, __HIP_MEMORY_SCOPE_AGENT); } }
    }
};
struct EpiConv {
    static constexpr bool PERM = false, AFTER_DRAIN = false;
    bf16_t* ACT; const float* cw; const float* cb; float* GL; float* GF; float* VF; const unsigned long long* ss;
    __device__ __forceinline__ void operator()(const f32x4 (&acc)[2][2][4][2], const Unit& u, int wr, int wc, int fr, int fq) const {
        constexpr int FF = 5504;
        const int lane = otid() & 63;
        const int src1 = (lane & 48) | ((fr + 15) & 15), src2 = (lane & 48) | ((fr + 14) & 15);
        float rs[2][4];
#pragma unroll
        for (int ai = 0; ai < 2; ++ai)
#pragma unroll
            for (int m = 0; m < 4; ++m) rs[ai][m] = __builtin_amdgcn_rsqf((float)ss[u.pm * BM + ai * HALF + wr * 64 + m * 16 + fr] * (1.f / (2048.f * 262144.f)) + 1e-6f);
#pragma unroll
        for (int n = 0; n < 2; ++n) {
            const int cbase = 128 * u.pn + 32 * wc + 16 * n + 4 * fq;
            const f32x4 w0 = *(const f32x4*)(cw + cbase), w1 = *(const f32x4*)(cw + FF + cbase), w2 = *(const f32x4*)(cw + 2 * FF + cbase), b4 = *(const f32x4*)(cb + cbase);
#pragma unroll
            for (int ai = 0; ai < 2; ++ai) {
                const int slab = u.pm * 4 + 2 * ai + wr;
                f32x4 r1p = (f32x4){0.f, 0.f, 0.f, 0.f}, r2p = (f32x4){0.f, 0.f, 0.f, 0.f};
#pragma unroll
                for (int m = 0; m < 4; ++m) {
                    const f32x4 g = acc[ai][1][m][n] * rs[ai][m], v = acc[ai][0][m][n] * rs[ai][m];
                    f32x4 r1, r2, a;
#pragma unroll
                    for (int e = 0; e < 4; ++e) { r1[e] = __shfl(g[e], src1); r2[e] = __shfl(g[e], src2); }
#pragma unroll
                    for (int e = 0; e < 4; ++e) {
                        const float p1 = fr >= 1 ? r1[e] : r1p[e], p2 = fr >= 2 ? r2[e] : r2p[e];
                        const float gg = b4[e] + w0[e] * p2 + w1[e] * p1 + w2[e] * g[e];
                        a[e] = gg * __builtin_amdgcn_rcpf(1.f + __expf(-gg)) * v[e];
                    }
                    r1p = r1; r2p = r2;
                    const size_t row = (size_t)(u.pm * BM + ai * HALF + wr * 64 + m * 16 + fr);
                    if (m == 0 && fr < 2) {
                        *(f32x4*)(GF + (size_t)(slab * 2 + fr) * FF + cbase) = g; *(f32x4*)(VF + (size_t)(slab * 2 + fr) * FF + cbase) = v;
                    } else {
                        typedef unsigned u32x2v __attribute__((ext_vector_type(2)));
                        u32x2v w; w.x = cvt_pk_bf16(a[0], a[1]); w.y = cvt_pk_bf16(a[2], a[3]);
                        *(u32x2v*)(ACT + row * FF + cbase) = w;
                    }
                    if (m == 3 && fr >= 14) *(f32x4*)(GL + (size_t)(slab * 2 + fr - 14) * FF + cbase) = g;
                }
            }
        }
    }
};
template <class Epi, class Sched, bool ALIGN_EPI = false, bool SP2 = false>
__device__ __forceinline__ void gemm_phase(PG8_LAS unsigned char* lds, const Gemm g, const Sched& S, const Epi& E) {
    const int tid = otid(), wid = __builtin_amdgcn_readfirstlane(tid >> 6), lane = tid & 63, wr = wid >> 2, wc = wid & 3, fr = lane & 15, fq = lane >> 4;
    const int K = g.K, nt = K / BK;
    unsigned voffA[2], voffB[2];
#pragma unroll
    for (int i = 0; i < 2; ++i) { int R, C; stage_rc(tid * 16 + i * 8192, R, C); const int Rb = Epi::PERM ? ((R & ~31) + perm32(R & 31)) : R;
        voffA[i] = (unsigned)(R * K + C) * 2u; voffB[i] = (unsigned)(Rb * K + C) * 2u; }
    const size_t kstep = (size_t)(BK * 2);
    const size_t hstep = (size_t)HALF * K * 2;
    const size_t tstep = 2 * hstep;
    const unsigned ldsw = (unsigned)wid * 1024u;
    const int aoff = lds_byte(wr * 64 + fr, fq * 8), boff = lds_byte(wc * 32 + fr, fq * 8);
#define PG8_SA(b, h) (((b) * 2 + (h)) * HTB)
#define PG8_SB(b, h) ((4 + (b) * 2 + (h)) * HTB)
#define PG8_STAGE(bufoff, gbase, voff) do { _Pragma("unroll") for (int _i = 0; _i < 2; ++_i) \
        __builtin_amdgcn_global_load_lds((const unsigned*)((const char*)(gbase) + (voff)[_i]), (PG8_LAS unsigned*)(lds + (bufoff) + ldsw + _i * 8192), 16, 0, 0); } while (0)
#define PG8_LDA(dst, b, h) do { _Pragma("unroll") for (int m = 0; m < 4; ++m) _Pragma("unroll") for (int k = 0; k < 2; ++k) dst[m][k] = *(const PG8_LAS bf16x8*)(lds + PG8_SA(b, h) + aoff + m * 2048 + k * 1024); } while (0)
#define PG8_LDB(dst, b, h) do { _Pragma("unroll") for (int n = 0; n < 2; ++n) _Pragma("unroll") for (int k = 0; k < 2; ++k) dst[n][k] = *(const PG8_LAS bf16x8*)(lds + PG8_SB(b, h) + boff + n * 2048 + k * 1024); } while (0)
#define PG8_MMA(ai, bj, At, Bt) do { __builtin_amdgcn_s_setprio(1); _Pragma("unroll") for (int m = 0; m < 4; ++m) _Pragma("unroll") for (int n = 0; n < 2; ++n) _Pragma("unroll") for (int k = 0; k < 2; ++k) \
        acc[ai][bj][m][n] = __builtin_amdgcn_mfma_f32_16x16x32_bf16(Bt[n][k], At[m][k], acc[ai][bj][m][n], 0, 0, 0); __builtin_amdgcn_s_setprio(0); } while (0)
#define PG8_WAIT_V(n) asm volatile("s_waitcnt vmcnt(" #n ")" ::: "memory")
#define PG8_WAIT_L(n) asm volatile("s_waitcnt lgkmcnt(" #n ")" ::: "memory")
#define PG8_BAR __builtin_amdgcn_s_barrier()
#define PG8_SCHED __builtin_amdgcn_sched_barrier(0)
    Unit cur, nxt; int ui = 0;
    if (!S.next(0, cur)) return;
    f32x4 acc[2][2][4][2];
#pragma unroll
    for (int a = 0; a < 2; ++a)
#pragma unroll
        for (int b = 0; b < 2; ++b)
#pragma unroll
            for (int m = 0; m < 4; ++m)
#pragma unroll
                for (int n = 0; n < 2; ++n) acc[a][b][m][n] = (f32x4){0.f, 0.f, 0.f, 0.f};
    bf16x8 At[4][2], B0[2][2], B1[2][2];
    const char* cA = (const char*)g.A + (size_t)cur.pm * tstep; const char* cB = (const char*)g.Bt + (size_t)cur.pn * tstep;
    S.a_ready(cur);
    if constexpr (SP2) {
        PG8_STAGE(PG8_SB(0, 0), cB, voffB); PG8_STAGE(PG8_SB(0, 1), cB + hstep, voffB); PG8_STAGE(PG8_SA(0, 0), cA, voffA); PG8_STAGE(PG8_SA(0, 1), cA + hstep, voffA);
        if (wr == 1) PG8_BAR;
        PG8_WAIT_V(2); PG8_BAR;
        PG8_STAGE(PG8_SB(1, 0), cB + kstep, voffB); PG8_STAGE(PG8_SA(1, 0), cA + kstep, voffA); PG8_STAGE(PG8_SB(1, 1), cB + hstep + kstep, voffB);
        PG8_WAIT_V(6); PG8_BAR;
    } else {
        PG8_STAGE(PG8_SB(0, 0), cB, voffB); PG8_STAGE(PG8_SA(0, 0), cA, voffA); PG8_STAGE(PG8_SB(0, 1), cB + hstep, voffB); PG8_STAGE(PG8_SA(0, 1), cA + hstep, voffA);
        if (wr == 1) PG8_BAR;
        PG8_WAIT_V(4); PG8_BAR;
        PG8_STAGE(PG8_SB(1, 0), cB + kstep, voffB); PG8_STAGE(PG8_SA(1, 0), cA + kstep, voffA); PG8_STAGE(PG8_SB(1, 1), cB + hstep + kstep, voffB);
        PG8_WAIT_V(6); PG8_BAR;
    }
    for (;;) {
        const bool has_next = S.next(ui + 1, nxt);
        const char* nA = has_next ? (const char*)g.A + (size_t)nxt.pm * tstep : cA; const char* nB = has_next ? (const char*)g.Bt + (size_t)nxt.pn * tstep : cB;
        for (int t = 0; t < nt; t += 2) {
            const bool last = (t == nt - 2);
            const char* a1 = cA + (size_t)(t + 1) * kstep;
            const char* a2 = last ? nA : cA + (size_t)(t + 2) * kstep; const char* b2 = last ? nB : cB + (size_t)(t + 2) * kstep;
            const char* a3 = a2 + kstep; const char* b3 = b2 + kstep;
            if (last && has_next) S.a_ready(nxt);
            if constexpr (SP2) {
            PG8_LDB(B0, 0, 0); PG8_LDB(B1, 0, 1); PG8_SCHED; PG8_LDA(At, 0, 0); PG8_STAGE(PG8_SA(1, 1), a1 + hstep, voffA);
            PG8_WAIT_V(8); PG8_WAIT_L(0); PG8_BAR; PG8_MMA(0, 0, At, B0); PG8_MMA(0, 1, At, B1); PG8_BAR; PG8_SCHED;
            PG8_LDA(At, 0, 1); PG8_STAGE(PG8_SB(0, 0), b2, voffB); PG8_STAGE(PG8_SB(0, 1), b2 + hstep, voffB); PG8_STAGE(PG8_SA(0, 0), a2, voffA);
            PG8_WAIT_V(8); PG8_WAIT_L(0); PG8_BAR; PG8_MMA(1, 0, At, B0); PG8_MMA(1, 1, At, B1); PG8_BAR; PG8_SCHED;
            PG8_LDB(B0, 1, 0); PG8_LDB(B1, 1, 1); PG8_SCHED; PG8_LDA(At, 1, 0); PG8_STAGE(PG8_SA(0, 1), a2 + hstep, voffA);
            PG8_WAIT_V(8); PG8_WAIT_L(0); PG8_BAR; PG8_MMA(0, 0, At, B0); PG8_MMA(0, 1, At, B1); PG8_BAR; PG8_SCHED;
            PG8_LDA(At, 1, 1); PG8_STAGE(PG8_SB(1, 0), b3, voffB); PG8_STAGE(PG8_SB(1, 1), b3 + hstep, voffB); PG8_STAGE(PG8_SA(1, 0), a3, voffA);
            PG8_WAIT_V(8); PG8_WAIT_L(0); PG8_BAR; PG8_MMA(1, 0, At, B0); PG8_MMA(1, 1, At, B1); PG8_BAR; PG8_SCHED;
            } else {
            PG8_LDB(B0, 0, 0); PG8_SCHED; PG8_LDA(At, 0, 0); PG8_STAGE(PG8_SA(1, 1), a1 + hstep, voffA);
            PG8_WAIT_L(8); PG8_BAR; PG8_WAIT_L(0); PG8_MMA(0, 0, At, B0); PG8_BAR; PG8_SCHED;
            PG8_LDB(B1, 0, 1); PG8_STAGE(PG8_SB(0, 0), b2, voffB);
            PG8_BAR; PG8_WAIT_L(0); PG8_MMA(0, 1, At, B1); PG8_BAR;
            PG8_LDA(At, 0, 1); PG8_STAGE(PG8_SA(0, 0), a2, voffA);
            PG8_BAR; PG8_WAIT_L(0); PG8_MMA(1, 0, At, B0); PG8_BAR; PG8_SCHED;
            PG8_STAGE(PG8_SB(0, 1), b2 + hstep, voffB);
            PG8_WAIT_V(6); PG8_BAR; PG8_MMA(1, 1, At, B1); PG8_BAR;
            PG8_LDB(B0, 1, 0); PG8_SCHED; PG8_LDA(At, 1, 0); PG8_STAGE(PG8_SA(0, 1), a2 + hstep, voffA);
            PG8_WAIT_L(8); PG8_BAR; PG8_WAIT_L(0); PG8_MMA(0, 0, At, B0); PG8_BAR; PG8_SCHED;
            PG8_LDB(B1, 1, 1); PG8_STAGE(PG8_SB(1, 0), b3, voffB);
            PG8_BAR; PG8_WAIT_L(0); PG8_MMA(0, 1, At, B1); PG8_BAR;
            PG8_LDA(At, 1, 1); PG8_STAGE(PG8_SA(1, 0), a3, voffA);
            PG8_BAR; PG8_WAIT_L(0); PG8_MMA(1, 0, At, B0); PG8_BAR; PG8_SCHED;
            PG8_STAGE(PG8_SB(1, 1), b3 + hstep, voffB);
            PG8_WAIT_V(6); PG8_BAR; PG8_MMA(1, 1, At, B1); PG8_BAR;
            }
        }
        if constexpr (ALIGN_EPI) { if (wr == 0) PG8_BAR; }
        if constexpr (!Epi::AFTER_DRAIN) { E(acc, cur, wr, wc, fr, fq); S.done(cur); }
        if (!has_next) break;
#pragma unroll
        for (int a = 0; a < 2; ++a)
#pragma unroll
            for (int b = 0; b < 2; ++b)
#pragma unroll
                for (int m = 0; m < 4; ++m)
#pragma unroll
                    for (int n = 0; n < 2; ++n) acc[a][b][m][n] = (f32x4){0.f, 0.f, 0.f, 0.f};
        cur = nxt; cA = nA; cB = nB; ++ui;
        if constexpr (ALIGN_EPI) { if (wr == 1) PG8_BAR; }
    }
    PG8_WAIT_V(0);
    if constexpr (!ALIGN_EPI) { if (wr == 0) PG8_BAR; }
    PG8_BAR;
    if constexpr (Epi::AFTER_DRAIN) { E.fused(acc, cur, wr, wc, fr, fq, lds, wid, lane); S.done(cur); }
#undef PG8_SA
#undef PG8_SB
#undef PG8_STAGE
#undef PG8_LDA
#undef PG8_LDB
#undef PG8_MMA
#undef PG8_WAIT_V
#undef PG8_WAIT_L
#undef PG8_BAR
#undef PG8_SCHED
}
}
#define DI __device__ __forceinline__
#define LAS __attribute__((address_space(3)))
typedef unsigned short bf16;
typedef short bf16x8 __attribute__((ext_vector_type(8)));
typedef short s16x4 __attribute__((ext_vector_type(4)));
typedef float f32x4 __attribute__((ext_vector_type(4)));
typedef float f32x16 __attribute__((ext_vector_type(16)));
typedef unsigned u32x4 __attribute__((ext_vector_type(4)));
typedef unsigned u32x2 __attribute__((ext_vector_type(2)));
constexpr int D = 2048, BATCH = 4, SEQ = 8192, T = BATCH * SEQ, DEPTH = 2, MEMLEN = 256;
constexpr int PROJW = 6168, PROJN = 6400;
constexpr int QAP = 2304, PROJP = 4224;
constexpr int O_QA = 0, O_KA = 768, O_VA = 1536, O_QB = 0, O_KB = 512, O_VB = 1024, O_FL = 1536, O_QC = 1544, O_KC = 1928, O_VC = 2312, O_RC = 3080, O_GL = 3848;
constexpr int DFF = 5504, CW = 512;
constexpr float LOG2E = 1.4426950408889634f, EPS = 1e-6f;
constexpr int NWAVES = 8, NTHR = 512;
constexpr int LDS_BYTES = 150528;
constexpr size_t MiB = 1u << 20;
constexpr size_t WS_CTL = 0, WS_C2 = 1 * MiB, WS_DEC = 2 * MiB, WS_LSE = 3 * MiB, WS_MEMN = 8 * MiB, WS_KVC = 12 * MiB;
constexpr size_t WS_WIN = 16 * MiB, WS_WOUT = 41 * MiB, WS_WCQ = 49 * MiB, WS_WCKV = 51 * MiB, WS_WCO = 55 * MiB, WS_WUP = 57 * MiB, WS_WDOWN = 100 * MiB;
constexpr size_t WS_XN = 122 * MiB, WS_QKVA = 250 * MiB, WS_PROJ = 394 * MiB, WS_ACT = 266 * MiB, WS_QC = 266 * MiB, WS_OC = 298 * MiB;
constexpr size_t WS_MIXED = 666 * MiB, WS_SC = 794 * MiB, WS_GL = 794 * MiB, WS_GF = 816 * MiB, WS_VF = 838 * MiB, WS_END = 938 * MiB;

DI float wave_sum(float v) {
#pragma unroll
    for (int o = 1; o < 64; o <<= 1) v += __shfl_xor(v, o);
    return v;
}
DI unsigned f2bf(float f) { unsigned u = __builtin_bit_cast(unsigned, f); return (u + 0x7fffu + ((u >> 16) & 1u)) >> 16; }
DI float bf2f(unsigned short b) { return __builtin_bit_cast(float, (unsigned)b << 16); }
DI float bflo(unsigned w) { return __builtin_bit_cast(float, w << 16); }
DI float bfhi(unsigned w) { return __builtin_bit_cast(float, w & 0xffff0000u); }
DI float logsig(float x) { return fminf(x, 0.f) - log1pf(expf(-fabsf(x))); }
DI int crow(int r, int hi) { return (r & 3) + 8 * (r >> 2) + 4 * hi; }
#define MFMA32(a, b, c) __builtin_amdgcn_mfma_f32_32x32x16_bf16((a), (b), (c), 0, 0, 0)
typedef short v4i16_t __attribute__((ext_vector_type(4)));
DI s16x4 trd(const LAS char* p) { return __builtin_bit_cast(s16x4, __builtin_amdgcn_ds_read_tr16_b64_v4i16((LAS v4i16_t*)p)); }
DI bf16x8 frag_row(const LAS char* base, int pitch, int row0, int k0, int lane) { return *(const LAS bf16x8*)(base + (row0 + (lane & 31)) * pitch + (k0 + 8 * (lane >> 5)) * 2); }
DI bf16x8 frag_tr(const LAS char* base, int pitch, int k0, int col0, int lane) {
    const int h = lane >> 5, blk = (lane >> 4) & 1, q = (lane & 15) >> 2, p = lane & 3;
    const LAS char* a = base + (k0 + 8 * h + q) * pitch + (col0 + 16 * blk) * 2 + 8 * p;
    const s16x4 lo = trd(a), hi = trd(a + 4 * pitch);
    return __builtin_shufflevector(lo, hi, 0, 1, 2, 3, 4, 5, 6, 7);
}
DI bf16x8 frag_tr_perm(const LAS char* base, int pitch, int k0, int col0, int lane) {
    const int h = lane >> 5, blk = (lane >> 4) & 1, q = (lane & 15) >> 2, p = lane & 3;
    const LAS char* a = base + (k0 + 4 * h + q) * pitch + (col0 + 16 * blk) * 2 + 8 * p;
    const s16x4 lo = trd(a), hi = trd(a + 8 * pitch);
    return __builtin_shufflevector(lo, hi, 0, 1, 2, 3, 4, 5, 6, 7);
}
typedef float f32x2_t __attribute__((ext_vector_type(2))); typedef __bf16 bf16x2_t __attribute__((ext_vector_type(2)));
DI unsigned cvtpk(float lo, float hi) { f32x2_t v = {lo, hi}; bf16x2_t b = __builtin_convertvector(v, bf16x2_t); return __builtin_bit_cast(unsigned, b); }
DI unsigned pk2(float lo, float hi) { return cvtpk(lo, hi); }
DI bf16x8 pack8(const f32x16& x, int s) { u32x4 p; p[0] = cvtpk(x[8 * s], x[8 * s + 1]); p[1] = cvtpk(x[8 * s + 2], x[8 * s + 3]); p[2] = cvtpk(x[8 * s + 4], x[8 * s + 5]); p[3] = cvtpk(x[8 * s + 6], x[8 * s + 7]); return __builtin_bit_cast(bf16x8, p); }

struct AttnU {
    const bf16* Qb; long qstride; const bf16* Kb; const bf16* Vb; long kstride; bf16* Ob; long ostride;
    int NT, t_begin;
    const float* cq; const float* ck; int q0;
    float* lse; long lstride;
};
template <int DH, int MODE>
DI void attn_unit(LAS char* lds, const AttnU& u, const LAS float* tbl) {
    constexpr int PITCH = DH * 2 + 16, TILEB = 64 * PITCH, BUFB = 2 * TILEB + 256, NCH = DH / 8, PER = NCH / 8;
    const int tid = otid(), lane = tid & 63, r32 = lane & 31, hi = lane >> 5; const int w = __builtin_amdgcn_readfirstlane(tid >> 6);
    bf16x8 qf[DH / 16];
    { const bf16* qrow = u.Qb + (long)(32 * w + r32) * u.qstride;
#pragma unroll
      for (int d0 = 0; d0 < DH / 16; ++d0) qf[d0] = *(const bf16x8*)(qrow + 16 * d0 + 8 * hi); }
    f32x16 o[DH / 32];
#pragma unroll
    for (int i = 0; i < DH / 32; ++i)
#pragma unroll
        for (int r = 0; r < 16; ++r) o[i][r] = 0.f;
    float m = -INFINITY, l = 0.f;
    u32x4 kreg[PER], vreg[PER]; float ckreg = 0.f;
    const int srow = (tid * PER) / NCH, sch = (tid * PER) % NCH;
#define AT_GLOAD(t) do { const long rr_ = (long)(64 * (t) + srow) * u.kstride + sch * 8; \
        _Pragma("unroll") for (int i_ = 0; i_ < PER; ++i_) { kreg[i_] = *(const u32x4*)(u.Kb + rr_ + 8 * i_); vreg[i_] = *(const u32x4*)(u.Vb + rr_ + 8 * i_); } \
        if (MODE == 1 && tid < 64) ckreg = u.ck[64 * (t) + tid]; } while (0)
#define AT_LWRITE(buf) do { LAS char* kb_ = lds + (buf) * BUFB + srow * PITCH + sch * 16; \
        _Pragma("unroll") for (int i_ = 0; i_ < PER; ++i_) { *(LAS u32x4*)(kb_ + 16 * i_) = kreg[i_]; *(LAS u32x4*)(kb_ + TILEB + 16 * i_) = vreg[i_]; } \
        if (MODE == 1 && tid < 64) *(LAS float*)(lds + (buf) * BUFB + 2 * TILEB + 4 * tid) = ckreg; } while (0)
    const int t0 = u.t_begin, NT = u.NT;
    AT_GLOAD(t0); AT_LWRITE(0); __syncthreads();
    for (int t = t0; t < NT; ++t) {
        const int cur = (t - t0) & 1;
        if (t + 1 < NT) AT_GLOAD(t + 1);
        const LAS char* Kt = lds + cur * BUFB; const LAS char* Vt = Kt + TILEB; const LAS float* ckl = (const LAS float*)(Kt + 2 * TILEB);
#pragma unroll
        for (int sub = 0; sub < 2; ++sub) {
            const int s = 2 * t + sub;
            bool active = true;
            if (MODE == 1) active = (32 * s <= u.q0 + 32 * w + 31);
            if (MODE == 2) active = (s >= w && s <= w + 4);
            if (active) {
                f32x16 p;
#pragma unroll
                for (int r = 0; r < 16; ++r) p[r] = 0.f;
#pragma unroll
                for (int d0 = 0; d0 < DH / 16; ++d0) { const bf16x8 kf = frag_row(Kt, PITCH, 32 * sub, 16 * d0, lane); p = MFMA32(kf, qf[d0], p); }
                if (MODE == 1) {
                    const bool diag = (32 * s + 31 > u.q0 + 32 * w);
                    const int qa = u.q0 + 32 * w + r32, kb = 32 * s + 4 * hi;
#pragma unroll
                    for (int g = 0; g < 4; ++g) { const f32x4 c4 = *(const LAS f32x4*)(ckl + 32 * sub + 8 * g + 4 * hi);
#pragma unroll
                        for (int e = 0; e < 4; ++e) p[4 * g + e] -= c4[e]; }
                    if (diag) {
#pragma unroll
                        for (int r = 0; r < 16; ++r) { const int ka = kb + (r & 3) + 8 * (r >> 2); p[r] = (ka <= qa) ? p[r] : -INFINITY; } }
                }
                if (MODE == 2) {
                    const LAS float* tb = tbl + (32 + 128 + 32 * w + r32 - 32 * s - 4 * hi);
#pragma unroll
                    for (int r = 0; r < 16; ++r) p[r] += tb[-((r & 3) + 8 * (r >> 2))];
                }
                float mx = p[0];
#pragma unroll
                for (int r = 1; r < 16; ++r) mx = fmaxf(mx, p[r]);
                mx = fmaxf(mx, __shfl_xor(mx, 32));
                const float mn = fmaxf(m, mx);
                if (__any(mn > m)) {
                    const float mr_ = (mn == -INFINITY) ? 0.f : mn;
                    const float alpha = __builtin_amdgcn_exp2f(m - mr_);
                    l *= alpha;
#pragma unroll
                    for (int i = 0; i < DH / 32; ++i)
#pragma unroll
                        for (int r = 0; r < 16; ++r) o[i][r] *= alpha;
                    m = mn;
                }
                const float mref = (m == -INFINITY) ? 0.f : m;
#pragma unroll
                for (int r = 0; r < 16; ++r) { p[r] = __builtin_amdgcn_exp2f(p[r] - mref); l += p[r]; }
                const bf16x8 pb0 = pack8(p, 0), pb1 = pack8(p, 1);
#pragma unroll
                for (int db = 0; db < DH / 32; ++db) {
                    const bf16x8 v0 = frag_tr_perm(Vt, PITCH, 32 * sub, 32 * db, lane), v1 = frag_tr_perm(Vt, PITCH, 32 * sub + 16, 32 * db, lane);
                    o[db] = MFMA32(v0, pb0, o[db]); o[db] = MFMA32(v1, pb1, o[db]);
                }
            }
        }
        if (t + 1 < NT) AT_LWRITE(cur ^ 1);
        __syncthreads();
    }
#undef AT_GLOAD
#undef AT_LWRITE
    l += __shfl_xor(l, 32);
    const float inv = 1.f / l;
    bf16* orow = u.Ob + (long)(32 * w + r32) * u.ostride;
#pragma unroll
    for (int db = 0; db < DH / 32; ++db)
#pragma unroll
        for (int g = 0; g < 4; ++g) { u32x2 wv; wv.x = cvtpk(o[db][4 * g] * inv, o[db][4 * g + 1] * inv); wv.y = cvtpk(o[db][4 * g + 2] * inv, o[db][4 * g + 3] * inv);
            *(u32x2*)(orow + 32 * db + 8 * g + 4 * hi) = wv; }
    if (MODE == 2 && hi == 0) u.lse[(long)(32 * w + r32) * u.lstride] = m + __log2f(l);
}
DI void norm_row_bf16(const float* xrow, const float* g, bf16* orow, int lane) {
    const f32x4* xr = (const f32x4*)xrow + lane; const f32x4* gr = (const f32x4*)g + lane;
    f32x4 v[8]; float s = 0.f;
#pragma unroll
    for (int j = 0; j < 8; ++j) { v[j] = xr[64 * j]; s += (v[j].x * v[j].x + v[j].y * v[j].y) + (v[j].z * v[j].z + v[j].w * v[j].w); }
    const float rstd = 1.f / sqrtf(wave_sum(s) * (1.f / D) + EPS);
    u32x2* o8 = (u32x2*)orow + lane;
#pragma unroll
    for (int j = 0; j < 8; ++j) { const f32x4 gg = gr[64 * j]; u32x2 w; w.x = pk2(v[j].x * rstd * gg.x, v[j].y * rstd * gg.y); w.y = pk2(v[j].z * rstd * gg.z, v[j].w * rstd * gg.w); o8[64 * j] = w; }
}
DI void xconv_row(const float* xrow, bf16* orow, unsigned long long* ssrow, int lane) {
    const f32x4* xr = (const f32x4*)xrow + lane;
    f32x4 v[8]; float s = 0.f;
#pragma unroll
    for (int j = 0; j < 8; ++j) { v[j] = xr[64 * j]; s += (v[j].x * v[j].x + v[j].y * v[j].y) + (v[j].z * v[j].z + v[j].w * v[j].w); }
    s = wave_sum(s); if (lane == 0) *ssrow = (unsigned long long)(s * 262144.f + 0.5f);
    u32x2* o8 = (u32x2*)orow + lane;
#pragma unroll
    for (int j = 0; j < 8; ++j) { u32x2 w; w.x = pk2(v[j].x, v[j].y); w.y = pk2(v[j].z, v[j].w); o8[64 * j] = w; }
}
DI void norm_row_out(const bf16* xrow, const float* g, float* orow, int lane) {
    const u32x4* xr = (const u32x4*)xrow + lane; const f32x4* gr = (const f32x4*)g; f32x4* o4 = (f32x4*)orow;
    float v[32]; float s = 0.f;
#pragma unroll
    for (int j = 0; j < 4; ++j) { const u32x4 w = xr[64 * j];
#pragma unroll
        for (int q = 0; q < 4; ++q) { v[8 * j + 2 * q] = bflo(w[q]); v[8 * j + 2 * q + 1] = bfhi(w[q]); s += v[8 * j + 2 * q] * v[8 * j + 2 * q] + v[8 * j + 2 * q + 1] * v[8 * j + 2 * q + 1]; } }
    const float rstd = 1.f / sqrtf(wave_sum(s) * (1.f / D) + EPS);
#pragma unroll
    for (int j = 0; j < 4; ++j) { const int c4 = (64 * j + lane) * 2;
        const f32x4 g0 = gr[c4], g1 = gr[c4 + 1];
        o4[c4] = (f32x4){v[8 * j] * rstd * g0.x, v[8 * j + 1] * rstd * g0.y, v[8 * j + 2] * rstd * g0.z, v[8 * j + 3] * rstd * g0.w};
        o4[c4 + 1] = (f32x4){v[8 * j + 4] * rstd * g1.x, v[8 * j + 5] * rstd * g1.y, v[8 * j + 6] * rstd * g1.z, v[8 * j + 7] * rstd * g1.w}; }
}
DI float win_scale(int n) {
    if (n < 768) return 0.125f * LOG2E;
    if (n >= 2304 && n < 2816) return 0.125f * LOG2E;
    if (n >= 3848 && n < 4232) return 0.10206207261596575f;
    return 1.f;
}
template <int MODE>
DI void wt_item(const float* W, int K, int N, bf16* WT, LAS float* scr, int item, int nblk, float sc, const float* gk, int lane) {
    const int kb = item / nblk, nb = item % nblk, k0 = 64 * kb, nd0 = 32 * nb;
    int ns0 = nd0;
    if (MODE == 2) { const int pn = nd0 >> 8, bj = (nd0 >> 7) & 1, j = nd0 & 127; ns0 = bj * DFF + 128 * pn + j; }
    { const int n4 = (lane & 7) * 4, nsrc = ns0 + n4; const bool ok = nsrc < N;
      f32x4 v[8];
#pragma unroll
      for (int i = 0; i < 8; ++i) { const int kk = (lane >> 3) + 8 * i; v[i] = ok ? *(const f32x4*)(W + (size_t)(k0 + kk) * N + nsrc) : (f32x4){0.f, 0.f, 0.f, 0.f}; }
#pragma unroll
      for (int i = 0; i < 8; ++i) { const int kk = (lane >> 3) + 8 * i; const float gsc = gk ? gk[k0 + kk] : 1.f; LAS float* d = scr + kk * 33 + n4;
          d[0] = v[i].x * gsc; d[1] = v[i].y * gsc; d[2] = v[i].z * gsc; d[3] = v[i].w * gsc; } }
    asm volatile("s_waitcnt lgkmcnt(0)" ::: "memory");
    const int c = lane & 7;
#pragma unroll
    for (int j = 0; j < 4; ++j) { const int n = (lane >> 3) + 8 * j; const LAS float* s = scr + (8 * c) * 33 + n;
        float f = sc; if (MODE == 1) f = win_scale(nd0 + n);
        u32x4 o; o.x = pk2(s[0 * 33] * f, s[1 * 33] * f); o.y = pk2(s[2 * 33] * f, s[3 * 33] * f); o.z = pk2(s[4 * 33] * f, s[5 * 33] * f); o.w = pk2(s[6 * 33] * f, s[7 * 33] * f);
        *(u32x4*)(WT + (size_t)(nd0 + n) * K + k0 + 8 * c) = o; }
    asm volatile("s_waitcnt lgkmcnt(0)" ::: "memory");
}
DI float logsig_fast(float x) { return fminf(x, 0.f) - __logf(1.f + __expf(-fabsf(x))); }
DI void fscan_chunk(LAS char* lds, int c, const bf16* PROJ, const float* fbias, float* C2, float* TOT) {
    LAS float* vals = (LAS float*)lds;
    const int tid = otid(), lane = tid & 63, w = tid >> 6;
    { const int t = tid >> 2, hq = tid & 3;
      const unsigned v = *(const unsigned*)(PROJ + ((size_t)c * 128 + t) * PROJP + O_FL + 2 * hq);
      vals[(2 * hq) * 128 + t] = logsig_fast(bflo(v) + fbias[2 * hq]) * LOG2E; vals[(2 * hq + 1) * 128 + t] = logsig_fast(bfhi(v) + fbias[2 * hq + 1]) * LOG2E; }
    __syncthreads();
    { const float a0 = vals[w * 128 + 2 * lane], a1 = vals[w * 128 + 2 * lane + 1]; const float sum = a0 + a1;
      float inc = sum;
#pragma unroll
      for (int o = 1; o < 64; o <<= 1) { const float nb = __shfl_up(inc, o); if (lane >= o) inc += nb; }
      const float ex = inc - sum;
      const int b = c >> 6, tb = (c & 63) * 128 + 2 * lane;
      float* dst = C2 + ((size_t)b * 8 + w) * SEQ + tb; dst[0] = ex + a0; dst[1] = ex + sum;
      if (lane == 63) TOT[c * 8 + w] = inc; }
    __syncthreads();
}
constexpr int G_OF = 0, G_BL = 0, G_QT = 49152, G_KT = 62464, G_VT = 75776, G_AM = 101376, G_SP = 110592, G_END = 148992;
constexpr int PQK = 208, PV = 400, PAM = 144;
static_assert(G_END <= LDS_BYTES, "gla lds");
template <int PH>
DI void gla_unit(LAS char* lds, int unit, const bf16* PROJ, const float* W2, const float* gb, bf16* SC, float* DEC, const float* cnorm, bf16* MIXED, bf16* QG, bf16* KG) {
    const int tid = otid(), lane = tid & 63, r32 = lane & 31, hi = lane >> 5; const int w = __builtin_amdgcn_readfirstlane(tid >> 6);
    const int bh = unit >> 7, n = unit & 127, b = bh >> 2, h = bh & 3;
    const size_t row0 = (size_t)b * SEQ + 64 * n;
    const int t = tid >> 3, kg = tid & 7;
    if (PH == 1) {
        LAS float* BL = (LAS float*)(lds + G_BL);
        u32x2 kv[3], qv[3];
        { const bf16* kp = PROJ + (row0 + t) * PROJP + O_KC + 96 * h + 12 * kg; const bf16* qp = PROJ + (row0 + t) * PROJP + O_QC + 96 * h + 12 * kg;
#pragma unroll
          for (int j = 0; j < 3; ++j) { kv[j] = *(const u32x2*)(kp + 4 * j); qv[j] = *(const u32x2*)(qp + 4 * j); } }
#pragma unroll
        for (int j = 0; j < 3; ++j) { const int c = tid + NTHR * j, tt = c / 24, ch = c - 24 * tt;
            *(LAS u32x4*)(lds + G_VT + tt * PV + ch * 16) = *(const u32x4*)(PROJ + (row0 + tt) * PROJP + O_VC + 192 * h + 8 * ch); }
        if (w < 3) {
            const int k = 32 * w + r32;
            bf16x8 bw; { u32x4 pw;
#pragma unroll
                for (int j = 0; j < 4; ++j) pw[j] = pk2(W2[(8 * hi + 2 * j) * 384 + 96 * h + k], W2[(8 * hi + 2 * j + 1) * 384 + 96 * h + k]);
                bw = __builtin_bit_cast(bf16x8, pw); }
            const float gbias = gb[96 * h + k];
            float carry = 0.f;
#pragma unroll
            for (int mi = 0; mi < 2; ++mi) {
                const bf16x8 ga = *(const bf16x8*)(PROJ + (row0 + 32 * mi + r32) * PROJP + O_GL + 8 * hi);
                f32x16 d;
#pragma unroll
                for (int r = 0; r < 16; ++r) d[r] = 0.f;
                d = MFMA32(ga, bw, d);
#pragma unroll
                for (int r = 0; r < 16; ++r) d[r] = logsig_fast(d[r] + gbias) * 0.0625f;
                float sg[4], ps[4];
#pragma unroll
                for (int g = 0; g < 4; ++g) { d[4 * g + 1] += d[4 * g]; d[4 * g + 2] += d[4 * g + 1]; d[4 * g + 3] += d[4 * g + 2]; sg[g] = d[4 * g + 3]; }
#pragma unroll
                for (int g = 0; g < 4; ++g) ps[g] = __shfl_xor(sg[g], 32);
                float base_ = carry;
#pragma unroll
                for (int g = 0; g < 4; ++g) { const float off = base_ + (hi ? ps[g] : 0.f);
#pragma unroll
                    for (int e = 0; e < 4; ++e) d[4 * g + e] += off;
                    base_ += sg[g] + ps[g]; }
                carry = base_;
#pragma unroll
                for (int r = 0; r < 16; ++r) BL[(32 * mi + crow(r, hi)) * 96 + k] = d[r];
            }
        }
        __syncthreads();
        { bf16* qg = QG + (row0 + t) * 384 + 96 * h + 12 * kg; bf16* kgp = KG + (row0 + t) * 384 + 96 * h + 12 * kg;
#pragma unroll
          for (int j = 0; j < 3; ++j) {
              float bb[4], bl[4];
#pragma unroll
              for (int e = 0; e < 4; ++e) { bb[e] = BL[t * 96 + 12 * kg + 4 * j + e]; bl[e] = BL[63 * 96 + 12 * kg + 4 * j + e]; }
              const float k0 = bflo(kv[j].x), k1 = bfhi(kv[j].x), k2 = bflo(kv[j].y), k3 = bfhi(kv[j].y);
              u32x2 o; o.x = pk2(k0 * __expf(bl[0] - bb[0]), k1 * __expf(bl[1] - bb[1])); o.y = pk2(k2 * __expf(bl[2] - bb[2]), k3 * __expf(bl[3] - bb[3]));
              *(LAS u32x2*)(lds + G_KT + t * PQK + (12 * kg + 4 * j) * 2) = o;
              u32x2 ok; ok.x = pk2(k0 * __expf(-bb[0]), k1 * __expf(-bb[1])); ok.y = pk2(k2 * __expf(-bb[2]), k3 * __expf(-bb[3]));
              *(u32x2*)(kgp + 4 * j) = ok;
              u32x2 oq; oq.x = pk2(bflo(qv[j].x) * __expf(bb[0]), bfhi(qv[j].x) * __expf(bb[1])); oq.y = pk2(bflo(qv[j].y) * __expf(bb[2]), bfhi(qv[j].y) * __expf(bb[3]));
              *(u32x2*)(qg + 4 * j) = oq;
          } }
        if (tid < 96) DEC[(size_t)unit * 96 + tid] = __expf(BL[63 * 96 + tid]);
        __syncthreads();
        bf16* dst = SC + (size_t)unit * 18432;
        for (int tile = w; tile < 18; tile += 8) { const int mi = tile / 6, ni = tile - 6 * mi;
            f32x16 c;
#pragma unroll
            for (int r = 0; r < 16; ++r) c[r] = 0.f;
#pragma unroll
            for (int s = 0; s < 4; ++s) { const bf16x8 a = frag_tr(lds + G_KT, PQK, 16 * s, 32 * mi, lane), bq = frag_tr(lds + G_VT, PV, 16 * s, 32 * ni, lane); c = MFMA32(a, bq, c); }
#pragma unroll
            for (int g = 0; g < 4; ++g) { u32x2 o; o.x = pk2(c[4 * g], c[4 * g + 1]); o.y = pk2(c[4 * g + 2], c[4 * g + 3]);
                *(u32x2*)(dst + (32 * ni + r32) * 96 + 32 * mi + 8 * g + 4 * hi) = o; } }
    } else {
        { const bf16* qg = QG + (row0 + t) * 384 + 96 * h + 12 * kg; const bf16* kgp = KG + (row0 + t) * 384 + 96 * h + 12 * kg;
#pragma unroll
          for (int j = 0; j < 3; ++j) { *(LAS u32x2*)(lds + G_QT + t * PQK + (12 * kg + 4 * j) * 2) = *(const u32x2*)(qg + 4 * j); *(LAS u32x2*)(lds + G_KT + t * PQK + (12 * kg + 4 * j) * 2) = *(const u32x2*)(kgp + 4 * j); } }
#pragma unroll
        for (int j = 0; j < 3; ++j) { const int c = tid + NTHR * j, tt = c / 24, ch = c - 24 * tt;
            *(LAS u32x4*)(lds + G_VT + tt * PV + ch * 16) = *(const u32x4*)(PROJ + (row0 + tt) * PROJP + O_VC + 192 * h + 8 * ch); }
        const bf16* src = SC + (size_t)unit * 18432;
#pragma unroll
        for (int j = 0; j < 5; ++j) { const int c = tid + NTHR * j; if (c < 2304) *(LAS u32x4*)(lds + G_SP + c * 16) = *(const u32x4*)(src + c * 8); }
        __syncthreads();
        if (w < 4) { const int mi = w >> 1, nj = w & 1;
            f32x16 c;
#pragma unroll
            for (int r = 0; r < 16; ++r) c[r] = 0.f;
#pragma unroll
            for (int s = 0; s < 6; ++s) { const bf16x8 a = frag_row(lds + G_QT, PQK, 32 * mi, 16 * s, lane), bq = frag_row(lds + G_KT, PQK, 32 * nj, 16 * s, lane); c = MFMA32(a, bq, c); }
#pragma unroll
            for (int r = 0; r < 16; ++r) { const int i = 32 * mi + crow(r, hi), j = 32 * nj + r32; const float val = (j <= i) ? c[r] : 0.f;
                *(LAS unsigned short*)(lds + G_AM + i * PAM + j * 2) = (unsigned short)f2bf(val); } }
        __syncthreads();
        LAS float* OF = (LAS float*)(lds + G_OF);
        for (int tile = w; tile < 12; tile += 8) { const int mi = tile / 6, ni = tile - 6 * mi;
            f32x16 c;
#pragma unroll
            for (int r = 0; r < 16; ++r) c[r] = 0.f;
#pragma unroll
            for (int s = 0; s < 6; ++s) { const bf16x8 a = frag_row(lds + G_QT, PQK, 32 * mi, 16 * s, lane), bq = frag_row(lds + G_SP, 192, 32 * ni, 16 * s, lane); c = MFMA32(a, bq, c); }
#pragma unroll
            for (int s = 0; s < 4; ++s) { const bf16x8 a = frag_row(lds + G_AM, PAM, 32 * mi, 16 * s, lane), bq = frag_tr(lds + G_VT, PV, 16 * s, 32 * ni, lane); c = MFMA32(a, bq, c); }
#pragma unroll
            for (int r = 0; r < 16; ++r) OF[(32 * mi + crow(r, hi)) * 192 + 32 * ni + r32] = c[r]; }
        __syncthreads();
        { const int i = tid >> 3, part = tid & 7;
          const LAS float* orow = OF + i * 192 + 24 * part;
          float ov[24]; float ss = 0.f;
#pragma unroll
          for (int j = 0; j < 24; ++j) { ov[j] = orow[j]; ss += ov[j] * ov[j]; }
          ss += __shfl_xor(ss, 1); ss += __shfl_xor(ss, 2); ss += __shfl_xor(ss, 4);
          const float rstd = 1.f / sqrtf(ss * (1.f / 192.f) + EPS);
          const bf16* rcp = PROJ + (row0 + i) * PROJP + O_RC + 192 * h + 24 * part;
          bf16* op = MIXED + (row0 + i) * D + 1280 + 192 * h + 24 * part;
          const float* cn = cnorm + 24 * part;
#pragma unroll
          for (int q = 0; q < 3; ++q) { const u32x4 rv = *(const u32x4*)(rcp + 8 * q); u32x4 o;
#pragma unroll
              for (int e = 0; e < 4; ++e) { const float r0 = bflo(rv[e]), r1 = bfhi(rv[e]);
                  const float y0 = ov[8 * q + 2 * e] * rstd * cn[8 * q + 2 * e] * (r0 * __builtin_amdgcn_rcpf(1.f + __expf(-r0))), y1 = ov[8 * q + 2 * e + 1] * rstd * cn[8 * q + 2 * e + 1] * (r1 * __builtin_amdgcn_rcpf(1.f + __expf(-r1)));
                  o[e] = pk2(y0, y1); }
              *(u32x4*)(op + 8 * q) = o; } }
    }
    __syncthreads();
}
struct DilU { const bf16* Qb; const bf16* Kb; bf16* Ob; float* lse; int qstride, kstride, ostride, lstride, row_lo; };
constexpr int DIL_PITCH = 144, DIL_KB = 0, DIL_VB = 384 * DIL_PITCH;
static_assert(2 * 384 * DIL_PITCH + 36 * 192 * 4 <= 149504, "dilated lds");
struct DilRegs { u32x4 k[6], v[6]; bf16x8 q[4]; };
constexpr int DIL_TBLS = 2 * 384 * DIL_PITCH;
#define DIL_GLOAD(U, RG) do { _Pragma("unroll") for (int i_ = 0; i_ < 6; ++i_) { const int c_ = tid + NTHR * i_, row_ = c_ >> 3, ch_ = c_ & 7; \
        if (row_ >= (U).row_lo) { const bf16* p_ = (U).Kb + (long)row_ * (U).kstride + 8 * ch_; RG.k[i_] = *(const u32x4*)p_; RG.v[i_] = *(const u32x4*)(p_ + (O_VA - O_KA)); } } \
        { const bf16* qrow_ = (U).Qb + (long)(tid >> 1 & ~31 | (tid & 31)) * (U).qstride; _Pragma("unroll") for (int d0_ = 0; d0_ < 4; ++d0_) RG.q[d0_] = *(const bf16x8*)(qrow_ + 16 * d0_ + 8 * ((tid >> 5) & 1)); } } while (0)
#define DIL_LWRITE(RG) do { _Pragma("unroll") for (int i_ = 0; i_ < 6; ++i_) { const int c_ = tid + NTHR * i_, row_ = c_ >> 3, ch_ = c_ & 7; \
        *(LAS u32x4*)(lds + DIL_KB + row_ * DIL_PITCH + 16 * ch_) = RG.k[i_]; *(LAS u32x4*)(lds + DIL_VB + row_ * DIL_PITCH + 16 * ch_) = RG.v[i_]; } } while (0)
DI void dil_compute(LAS char* lds, const DilU& u, const LAS float* tbl, int tid, const bf16x8 (&qf)[4]) {
    const int lane = tid & 63, r32 = lane & 31, hi = lane >> 5; const int w = __builtin_amdgcn_readfirstlane(tid >> 6);
    f32x16 o[2];
#pragma unroll
    for (int i = 0; i < 2; ++i)
#pragma unroll
        for (int r = 0; r < 16; ++r) o[i][r] = 0.f;
    float m = -INFINITY, l = 0.f;
    for (int a = 0; a < 5; ++a) {
        const int s = w + a;
        if (32 * s < u.row_lo) continue;
        const LAS char* Kt = lds + DIL_KB + 32 * s * DIL_PITCH; const LAS char* Vt = lds + DIL_VB + 32 * s * DIL_PITCH;
        f32x16 p;
#pragma unroll
        for (int r = 0; r < 16; ++r) p[r] = 0.f;
#pragma unroll
        for (int d0 = 0; d0 < 4; ++d0) { const bf16x8 kf = frag_row(Kt, DIL_PITCH, 0, 16 * d0, lane); p = MFMA32(kf, qf[d0], p); }
        { const LAS float* tb = tbl + (32 + 128 + r32 - 32 * a - 4 * hi);
#pragma unroll
          for (int r = 0; r < 16; ++r) p[r] += tb[-((r & 3) + 8 * (r >> 2))]; }
        float mx = p[0];
#pragma unroll
        for (int r = 1; r < 16; ++r) mx = fmaxf(mx, p[r]);
        mx = fmaxf(mx, __shfl_xor(mx, 32));
        const float mn = fmaxf(m, mx);
        if (__any(mn > m)) {
            const float mr_ = (mn == -INFINITY) ? 0.f : mn;
            const float alpha = __builtin_amdgcn_exp2f(m - mr_);
            l *= alpha;
#pragma unroll
            for (int i = 0; i < 2; ++i)
#pragma unroll
                for (int r = 0; r < 16; ++r) o[i][r] *= alpha;
            m = mn;
        }
        const float mref = (m == -INFINITY) ? 0.f : m;
#pragma unroll
        for (int r = 0; r < 16; ++r) { p[r] = __builtin_amdgcn_exp2f(p[r] - mref); l += p[r]; }
        const bf16x8 pb0 = pack8(p, 0), pb1 = pack8(p, 1);
#pragma unroll
        for (int db = 0; db < 2; ++db) {
            const bf16x8 v0 = frag_tr_perm(Vt, DIL_PITCH, 0, 32 * db, lane), v1 = frag_tr_perm(Vt, DIL_PITCH, 16, 32 * db, lane);
            o[db] = MFMA32(v0, pb0, o[db]); o[db] = MFMA32(v1, pb1, o[db]);
        }
    }
    l += __shfl_xor(l, 32);
    const float inv = 1.f / l;
    bf16* orow = u.Ob + (long)(32 * w + r32) * u.ostride;
#pragma unroll
    for (int db = 0; db < 2; ++db)
#pragma unroll
        for (int g = 0; g < 4; ++g) { u32x2 wv; wv.x = cvtpk(o[db][4 * g] * inv, o[db][4 * g + 1] * inv); wv.y = cvtpk(o[db][4 * g + 2] * inv, o[db][4 * g + 3] * inv);
            *(u32x2*)(orow + 32 * db + 8 * g + 4 * hi) = wv; }
    if (hi == 0) u.lse[(long)(32 * w + r32) * u.lstride] = m + __log2f(l);
}
#include <hip/hip_bf16.h>
namespace attn_body {
using bf16=__hip_bfloat16;
using bf16x8=__attribute__((ext_vector_type(8)))short;
using s16x4=__attribute__((ext_vector_type(4)))short;
using f32x16=__attribute__((ext_vector_type(16)))float;
using u32x4=__attribute__((ext_vector_type(4)))unsigned;
constexpr int SEQ=8192,D=64,DM=4224,DMO=2048;
constexpr int NW=8,QBLK=32,QB=QBLK*NW,KVBLK=64,NQB=SEQ/QB;
__device__ __forceinline__ int crow(int r,int hi){return (r&3)+8*(r>>2)+4*hi;}
#define SBAR() __builtin_amdgcn_sched_barrier(0)
__device__ __forceinline__ void cmask(f32x16&p0,f32x16&p1,int jb,int qrel,int hi){
  const float NEG=-INFINITY; int kb=64*jb+4*hi;
  #pragma unroll
  for(int r=0;r<16;++r){int kv=kb+(r&3)+8*(r>>2); if(kv>qrel)p0[r]=NEG; if(kv+32>qrel)p1[r]=NEG;}
}

constexpr int NSLOT=3, SLOTB=8192;
constexpr int LDS_K=0, LDS_V=NSLOT*SLOTB, LDS_WS=2*NSLOT*SLOTB, LDS_OST=LDS_WS+NW*64*4, LDS_CK=LDS_OST+NW*4096, LDS_BYTES=LDS_CK+SEQ*4;
constexpr float C2=0.125f*1.4426950408889634f;
__device__ __forceinline__ void glds16(const void*gsrc,unsigned lds_dst){unsigned keep;
  asm volatile("s_mov_b32 %0, m0\n\ts_mov_b32 m0, %2\n\ts_nop 0\n\tglobal_load_lds_dwordx4 %1, off\n\ts_mov_b32 m0, %0":"=&s"(keep):"v"(gsrc),"s"(lds_dst):"memory");}
__device__ __forceinline__ float max3f(float a,float b,float c){float r;asm("v_max3_f32 %0, %1, %2, %3":"=v"(r):"v"(a),"v"(b),"v"(c));return r;}
__device__ __forceinline__ float max2f(float a,float b){float r;asm("v_max_f32_e32 %0, %1, %2":"=v"(r):"v"(a),"v"(b));return r;}
__device__ __forceinline__ float fadd_s(float a,float b){float r;asm("v_add_f32_e32 %0, %1, %2":"=v"(r):"v"(a),"v"(b));return r;}
__device__ __forceinline__ float fsub_s(float a,float b){float r;asm("v_sub_f32_e32 %0, %1, %2":"=v"(r):"v"(a),"v"(b));return r;}
typedef float f32x2_t __attribute__((ext_vector_type(2))); typedef __bf16 bf16x2_t __attribute__((ext_vector_type(2)));
__device__ __forceinline__ unsigned cvtpk_s(float lo,float hi){f32x2_t v={lo,hi};bf16x2_t b=__builtin_convertvector(v,bf16x2_t);return __builtin_bit_cast(unsigned,b);}
#define WAIT_BAR(N) asm volatile("s_waitcnt vmcnt(" #N ") lgkmcnt(0)\n\ts_barrier":::"memory")

__device__ __forceinline__ void qkt(f32x16&p0,f32x16&p1,const char*Kslot,const bf16x8*qr,const f32x16&negm,int r32,int hi){
  const char*kb=Kslot+hi*1024+r32*16;
  #pragma unroll
  for(int d0=0;d0<4;++d0){
    const bf16x8 b0=*reinterpret_cast<const bf16x8*>(kb+d0*2048);
    const bf16x8 b1=*reinterpret_cast<const bf16x8*>(kb+d0*2048+512);
    if(d0==0){p0=__builtin_amdgcn_mfma_f32_32x32x16_bf16(b0,qr[0],negm,0,0,0);p1=__builtin_amdgcn_mfma_f32_32x32x16_bf16(b1,qr[0],negm,0,0,0);}
    else{p0=__builtin_amdgcn_mfma_f32_32x32x16_bf16(b0,qr[d0],p0,0,0,0);p1=__builtin_amdgcn_mfma_f32_32x32x16_bf16(b1,qr[d0],p1,0,0,0);}}
}
typedef __attribute__((address_space(3))) const char* lds_cptr;
typedef short v4i16_t __attribute__((ext_vector_type(4)));
__device__ __forceinline__ void kload8(bf16x8*kf,lds_cptr kp){
  kf[0]=*(const __attribute__((address_space(3))) bf16x8*)(kp);      kf[1]=*(const __attribute__((address_space(3))) bf16x8*)(kp+512);
  kf[2]=*(const __attribute__((address_space(3))) bf16x8*)(kp+2048); kf[3]=*(const __attribute__((address_space(3))) bf16x8*)(kp+2560);
  kf[4]=*(const __attribute__((address_space(3))) bf16x8*)(kp+4096); kf[5]=*(const __attribute__((address_space(3))) bf16x8*)(kp+4608);
  kf[6]=*(const __attribute__((address_space(3))) bf16x8*)(kp+6144); kf[7]=*(const __attribute__((address_space(3))) bf16x8*)(kp+6656);
}
__device__ __forceinline__ void kload2(bf16x8*kf,lds_cptr kp,int j){ kf[2*j]=*(const __attribute__((address_space(3))) bf16x8*)(kp+j*2048); kf[2*j+1]=*(const __attribute__((address_space(3))) bf16x8*)(kp+j*2048+512); }
__device__ __forceinline__ s16x4 vtr(lds_cptr p){ return __builtin_bit_cast(s16x4,__builtin_amdgcn_ds_read_tr16_b64_v4i16((__attribute__((address_space(3))) v4i16_t*)p)); }
__device__ __forceinline__ float rowmax(const f32x16&p0,const f32x16&p1){
  float a=max3f(p0[0],p0[1],p1[0]),b=max3f(p0[2],p0[3],p1[1]);a=max3f(a,p1[2],p1[3]);
  #pragma unroll
  for(int r=4;r<16;r+=4){a=max3f(a,p0[r],p0[r+1]);b=max3f(b,p0[r+2],p0[r+3]);a=max3f(a,p1[r],p1[r+1]);b=max3f(b,p1[r+2],p1[r+3]);}
  const float m=max2f(a,b);
  auto rr=__builtin_amdgcn_permlane32_swap(__float_as_uint(m),__float_as_uint(m),false,false);
  return max2f(__uint_as_float(rr[0]),__uint_as_float(rr[1]));
}
__device__ __forceinline__ void pv(f32x16*o,int vb,bf16x8 pa0,bf16x8 pa1,bf16x8 pa2,bf16x8 pa3){
  #pragma unroll
  for(int d0=0;d0<2;++d0){s16x4 lo[4],hi[4];
    #pragma unroll
    for(int ks=0;ks<4;++ks){
      asm volatile("ds_read_b64_tr_b16 %0,%1 offset:%c2":"=&v"(lo[ks]):"v"(vb),"i"(d0*4096+ks*1024):"memory");
      asm volatile("ds_read_b64_tr_b16 %0,%1 offset:%c2":"=&v"(hi[ks]):"v"(vb),"i"(d0*4096+ks*1024+512):"memory");}
    asm volatile("s_waitcnt lgkmcnt(0)":::"memory");SBAR();
    #define PK(k) (bf16x8){lo[k][0],lo[k][1],lo[k][2],lo[k][3],hi[k][0],hi[k][1],hi[k][2],hi[k][3]}
    o[d0]=__builtin_amdgcn_mfma_f32_32x32x16_bf16(pa0,PK(0),o[d0],0,0,0);
    o[d0]=__builtin_amdgcn_mfma_f32_32x32x16_bf16(pa1,PK(1),o[d0],0,0,0);
    o[d0]=__builtin_amdgcn_mfma_f32_32x32x16_bf16(pa2,PK(2),o[d0],0,0,0);
    o[d0]=__builtin_amdgcn_mfma_f32_32x32x16_bf16(pa3,PK(3),o[d0],0,0,0);
    #undef PK
  }
}

#ifndef ATTN_STORE16
#define ATTN_STORE16(p,v) (*(u32x4*)(p)=(v))
#endif
typedef float f32x4v __attribute__((ext_vector_type(4)));
template<int THRL> __device__ __forceinline__ void attn_unit(int b,int h,int qb,const bf16*Q,const bf16*__restrict__ K,const bf16*__restrict__ V,bf16*O,const float*__restrict__ ckg,const float*__restrict__ ckoff,int ts,char*shm){
  const int tid=otid(),lane=tid&63,r32=lane&31,hi=lane>>5; const int wid=__builtin_amdgcn_readfirstlane(tid>>6);
  const long rowbase=(long)b*SEQ; const int q0=qb*QB;
  const bf16*Qw=Q+(rowbase+q0+wid*QBLK)*DM+h*D;
  const bf16*Kh=K+(rowbase+(long)ts*KVBLK)*DM+h*D,*Vh=V+(rowbase+(long)ts*KVBLK)*DM+h*D;
  const lds_cptr shm3=(lds_cptr)shm;
  const unsigned lds0=(unsigned)(uintptr_t)shm;
  float*wsf=(float*)(shm+LDS_WS)+wid*64;
  const bf16*ksrc=Kh+(long)lane*DM+wid*8;
  const bf16*vsrc=Vh+(long)(16*(wid&3)+(lane>>2))*DM+(wid>>2)*32+(lane&3)*8;
  const unsigned kdst=lds0+LDS_K+wid*1024, vdst=lds0+LDS_V+wid*1024;
  #define DMA_K(t,slot) glds16(ksrc+(long)(t)*KVBLK*DM,(unsigned)__builtin_amdgcn_readfirstlane(kdst+(slot)))
  #define DMA_V(t,slot) glds16(vsrc+(long)(t)*KVBLK*DM,(unsigned)__builtin_amdgcn_readfirstlane(vdst+(slot)))
  const int vb0=(int)(lds0+LDS_V)+((lane>>4)&1)*32+(lane&3)*8+(4*hi+((lane&15)>>2))*64;
  const char*Kbase=shm+LDS_K; bf16x8 kf[8];
  const lds_cptr kp0=shm3+LDS_K+hi*1024+r32*16; const lds_cptr vp0=shm3+LDS_V+((lane>>4)&1)*32+(lane&3)*8+(4*hi+((lane&15)>>2))*64;
  const int NT=(q0+QB)/KVBLK-ts;
  { __attribute__((address_space(3))) float*ckw=(__attribute__((address_space(3))) float*)(shm3+LDS_CK); const int nck=NT*KVBLK, kofs=ts*KVBLK; float cv[16];
    _Pragma("unroll") for(int j_=0;j_<16;++j_){const int i=tid+NW*64*j_; cv[j_]=(i<nck)?ckg[i+kofs]+ckoff[((i+kofs)>>7)*8]:0.f;}
    _Pragma("unroll") for(int j_=0;j_<16;++j_){const int i=tid+NW*64*j_; if(i<nck)ckw[i]=cv[j_];} }
  DMA_K(0,0);DMA_V(0,0);DMA_K(1,SLOTB);
  bf16x8 qr[4];
  #pragma unroll
  for(int d0=0;d0<4;++d0)qr[d0]=*reinterpret_cast<const bf16x8*>(&Qw[(long)r32*DM+d0*16+hi*8]);
  float mhat=0.f,l_reg=0.f;f32x16 o[2];o[0]=f32x16{};o[1]=f32x16{};f32x16 negm=f32x16{};asm volatile("":"+v"(negm));
  const int qrel=wid*QBLK+r32;
  #define CMASK(P0,P1,t) do{int jb_=(t)-(NT-4); if(jb_>=0)cmask(P0,P1,jb_,qrel,hi);}while(0)
  const __attribute__((address_space(3))) float*ckl3=(const __attribute__((address_space(3))) float*)(shm3+LDS_CK)+4*hi;
  #define BIAS(P0,P1,t) do{ const __attribute__((address_space(3))) float*cb_=ckl3+64*(t); \
    _Pragma("unroll") for(int g_=0;g_<4;++g_){ const f32x4v a_=*(const __attribute__((address_space(3))) f32x4v*)(cb_+8*g_), b_=*(const __attribute__((address_space(3))) f32x4v*)(cb_+32+8*g_); \
      _Pragma("unroll") for(int e_=0;e_<4;++e_){ P0[4*g_+e_]-=a_[e_]; P1[4*g_+e_]-=b_[e_]; } } }while(0)
  bool resc=false;
  #define START(P0,P1) do{ const float rm=rowmax(P0,P1); resc=false; \
    { const float dl=rm; mhat=fadd_s(mhat,dl); \
      _Pragma("unroll") for(int r=0;r<16;++r){P0[r]=fsub_s(P0[r],dl);P1[r]=fsub_s(P1[r],dl);} \
      _Pragma("unroll") for(int r=0;r<16;++r)negm[r]=-mhat; asm volatile("":"+v"(negm)); } \
    _Pragma("unroll") for(int r=0;r<16;++r)P0[r]=__builtin_amdgcn_exp2f(P0[r]); }while(0)
  #define RESC() do{ if(resc){ asm volatile("s_waitcnt lgkmcnt(0)":::"memory"); \
      _Pragma("unroll") for(int d_=0;d_<2;++d_) _Pragma("unroll") for(int r=0;r<16;++r)o[d_][r]*=wsf[crow(r,hi)]; } }while(0)
  f32x16 pA0,pA1,pB0,pB1;
  int sl_prev=0,sl_cur=0,sl_next=SLOTB;
  #define ROT() do{sl_prev=sl_cur;sl_cur=sl_next;sl_next=(sl_next==(NSLOT-1)*SLOTB)?0:sl_next+SLOTB;}while(0)
  DMA_K(2,2*SLOTB);
  WAIT_BAR(3);
  qkt(pA0,pA1,Kbase,qr,negm,r32,hi);asm volatile("s_nop 15\n\ts_nop 7":"+v"(pA0),"+v"(pA1));CMASK(pA0,pA1,0);BIAS(pA0,pA1,0);
  START(pA0,pA1);
  _Pragma("unroll") for(int r=0;r<16;++r)pA1[r]=__builtin_amdgcn_exp2f(pA1[r]);
  WAIT_BAR(0);
  DMA_K(3,0);DMA_V(1,SLOTB);
  ROT();
  kload8(kf,kp0+sl_cur);
  WAIT_BAR(2);
  s16x4 vlo[8],vhi[8]; u32x4 pw0,pw1,pw2,pw3;
  #define PKW(P,B) cvtpk_s(P[B],P[B+1])
  #define PAF(k) __builtin_bit_cast(bf16x8,pw##k)
  #define VFR(i) (bf16x8){vlo[i][0],vlo[i][1],vlo[i][2],vlo[i][3],vhi[i][0],vhi[i][1],vhi[i][2],vhi[i][3]}
  #define PIN(x) asm volatile("":"+v"(x))
  #define MX3(a,b,c) __builtin_fmaxf(__builtin_fmaxf((a),(b)),(c))
  #define GAPA(MF,A0,A1,A2,A3,W0,W1,PW) do{ MF; sacc+=A0; sacc+=A1; sacc+=A2; sacc+=A3; PIN(sacc); W0; W1; PIN(PW); SBAR(); }while(0)
  #define EX(v) __builtin_amdgcn_exp2f(v)
  #define GAPB(MF,X,B) do{ MF; X[B]=EX(X[B]); X[B+1]=EX(X[B+1]); X[B+2]=EX(X[B+2]); X[B+3]=EX(X[B+3]); PIN(X); SBAR(); }while(0)
  #define VRD(i) do{ vlo[i]=vtr(vp_+(((i)>>2)*4096+((i)&3)*1024)); vhi[i]=vtr(vp_+(((i)>>2)*4096+((i)&3)*1024+512)); }while(0)
  #define KRD(G,j) do{ if(G){ kload2(kf,kp0+sl_next,j); SBAR(); } }while(0)
  #define STEP(C0,C1,P0,P1,t,GK,GV,GL) do{ SBAR(); \
    const lds_cptr vp_=vp0+sl_prev; \
    VRD(0); SBAR(); float sacc=(P0[0]+P0[1]); \
    GAPA(C0=__builtin_amdgcn_mfma_f32_32x32x16_bf16(kf[0],qr[0],negm,0,0,0), P0[2],P0[3],P0[4],P0[5],     pw0[0]=PKW(P0,0), pw0[1]=PKW(P0,2), pw0); \
    VRD(4); SBAR(); GAPA(C1=__builtin_amdgcn_mfma_f32_32x32x16_bf16(kf[1],qr[0],negm,0,0,0), P0[6],P0[7],P0[8],P0[9],     pw0[2]=PKW(P0,4), pw0[3]=PKW(P0,6), pw0); \
    VRD(1); SBAR(); GAPA(C0=__builtin_amdgcn_mfma_f32_32x32x16_bf16(kf[2],qr[1],C0,0,0,0),   P0[10],P0[11],P0[12],P0[13], pw1[0]=PKW(P0,8), pw1[1]=PKW(P0,10), pw1); \
    VRD(5); SBAR(); GAPA(C1=__builtin_amdgcn_mfma_f32_32x32x16_bf16(kf[3],qr[1],C1,0,0,0),   P0[14],P0[15],P1[0],P1[1],   pw1[2]=PKW(P0,12),pw1[3]=PKW(P0,14), pw1); \
    VRD(2); SBAR(); GAPA(C0=__builtin_amdgcn_mfma_f32_32x32x16_bf16(kf[4],qr[2],C0,0,0,0),   P1[2],P1[3],P1[4],P1[5],     pw2[0]=PKW(P1,0), pw2[1]=PKW(P1,2), pw2); \
    VRD(6); SBAR(); GAPA(C1=__builtin_amdgcn_mfma_f32_32x32x16_bf16(kf[5],qr[2],C1,0,0,0),   P1[6],P1[7],P1[8],P1[9],     pw2[2]=PKW(P1,4), pw2[3]=PKW(P1,6), pw2); \
    VRD(3); SBAR(); GAPA(C0=__builtin_amdgcn_mfma_f32_32x32x16_bf16(kf[6],qr[3],C0,0,0,0),   P1[10],P1[11],P1[12],P1[13], pw3[0]=PKW(P1,8), pw3[1]=PKW(P1,10), pw3); \
    VRD(7); SBAR(); GAPA(C1=__builtin_amdgcn_mfma_f32_32x32x16_bf16(kf[7],qr[3],C1,0,0,0),   P1[14],P1[15],0.f,0.f,       pw3[2]=PKW(P1,12),pw3[3]=PKW(P1,14), pw3); \
    l_reg+=sacc; \
    if(GK){DMA_K((t)+3,sl_cur);} if(GV){DMA_V((t)+1,sl_next);} \
    CMASK(C0,C1,t); BIAS(C0,C1,t); \
    { float a=MX3(C0[0],C0[1],C1[0]),b=MX3(C0[2],C0[3],C1[1]); a=MX3(a,C1[2],C1[3]); \
      _Pragma("unroll") for(int r=4;r<16;r+=4){a=MX3(a,C0[r],C0[r+1]);b=MX3(b,C0[r+2],C0[r+3]);a=MX3(a,C1[r],C1[r+1]);b=MX3(b,C1[r+2],C1[r+3]);} \
      float rm=__builtin_fmaxf(a,b); { auto rr=__builtin_amdgcn_permlane32_swap(__float_as_uint(rm),__float_as_uint(rm),false,false); rm=__builtin_fmaxf(__uint_as_float(rr[0]),__uint_as_float(rr[1])); } \
      resc=false; \
      if(__builtin_expect(__any(rm>(float)THRL),0)){ const float dl=__builtin_fmaxf(rm,0.f); mhat+=dl; \
        _Pragma("unroll") for(int r=0;r<16;++r){C0[r]-=dl;C1[r]-=dl;} \
        _Pragma("unroll") for(int r=0;r<16;++r)negm[r]=-mhat; asm volatile("":"+v"(negm)); \
        const float f=__builtin_amdgcn_exp2f(-dl); l_reg*=f; if(hi==0)wsf[r32]=f; resc=true; } } \
    SBAR(); \
    GAPB(o[0]=__builtin_amdgcn_mfma_f32_32x32x16_bf16(PAF(0),VFR(0),o[0],0,0,0), C0,0); \
    GAPB(o[1]=__builtin_amdgcn_mfma_f32_32x32x16_bf16(PAF(0),VFR(4),o[1],0,0,0), C0,4); \
    KRD(GL,0); GAPB(o[0]=__builtin_amdgcn_mfma_f32_32x32x16_bf16(PAF(1),VFR(1),o[0],0,0,0), C0,8); \
    KRD(GL,1); GAPB(o[1]=__builtin_amdgcn_mfma_f32_32x32x16_bf16(PAF(1),VFR(5),o[1],0,0,0), C0,12); \
    KRD(GL,2); GAPB(o[0]=__builtin_amdgcn_mfma_f32_32x32x16_bf16(PAF(2),VFR(2),o[0],0,0,0), C1,0); \
    KRD(GL,3); GAPB(o[1]=__builtin_amdgcn_mfma_f32_32x32x16_bf16(PAF(2),VFR(6),o[1],0,0,0), C1,4); \
    GAPB(o[0]=__builtin_amdgcn_mfma_f32_32x32x16_bf16(PAF(3),VFR(3),o[0],0,0,0), C1,8); \
    GAPB(o[1]=__builtin_amdgcn_mfma_f32_32x32x16_bf16(PAF(3),VFR(7),o[1],0,0,0), C1,12); \
    }while(0)
  int t=1;
  #undef CMASK
  #define CMASK(P0,P1,t) do{}while(0)
  for(;t+5<NT;t+=2){
    STEP(pB0,pB1,pA0,pA1,t,true,true,true);     WAIT_BAR(2); RESC(); ROT();
    STEP(pA0,pA1,pB0,pB1,t+1,true,true,true);   WAIT_BAR(2); RESC(); ROT();
  }
  #undef CMASK
  #define CMASK(P0,P1,t) do{int jb_=(t)-(NT-4); if(jb_>=0)cmask(P0,P1,jb_,qrel,hi);}while(0)
  #define ENDW(tt) do{ if((tt)+3<NT){WAIT_BAR(2);} else if((tt)+2<NT){WAIT_BAR(1);} else {WAIT_BAR(0);} }while(0)
  for(;t+1<NT;t+=2){
    STEP(pB0,pB1,pA0,pA1,t,(t+3<NT),(t+1<NT),(t+1<NT));       ENDW(t);   RESC(); ROT();
    STEP(pA0,pA1,pB0,pB1,t+1,(t+4<NT),(t+2<NT),(t+2<NT));     ENDW(t+1); RESC(); ROT();
  }
  STEP(pB0,pB1,pA0,pA1,NT-1,false,false,false); RESC();
  { float sacc=pB0[0]+pB0[1]; _Pragma("unroll") for(int r=2;r<16;++r)sacc+=pB0[r]; _Pragma("unroll") for(int r=0;r<16;++r)sacc+=pB1[r]; l_reg+=sacc;
    pw0=(u32x4){PKW(pB0,0),PKW(pB0,2),PKW(pB0,4),PKW(pB0,6)};pw1=(u32x4){PKW(pB0,8),PKW(pB0,10),PKW(pB0,12),PKW(pB0,14)};pw2=(u32x4){PKW(pB1,0),PKW(pB1,2),PKW(pB1,4),PKW(pB1,6)};pw3=(u32x4){PKW(pB1,8),PKW(pB1,10),PKW(pB1,12),PKW(pB1,14)};
    SBAR(); pv(o,vb0+sl_cur,PAF(0),PAF(1),PAF(2),PAF(3)); }
  #undef PKW
  #undef PAF
  #undef VFR
  #undef PIN
  #undef MX3
  #undef GAPA
  #undef GAPB
  #undef EX
  #undef VRD
  #undef KRD
  #undef STEP
  #undef ENDW
  {auto rr=__builtin_amdgcn_permlane32_swap(__float_as_uint(l_reg),__float_as_uint(l_reg),false,false);l_reg=__uint_as_float(rr[0])+__uint_as_float(rr[1]);}
  if(hi==0)wsf[32+r32]=l_reg;asm volatile("s_waitcnt lgkmcnt(0)":::"memory");
  float rli[16];
  #pragma unroll
  for(int r=0;r<16;++r)rli[r]=__builtin_amdgcn_rcpf(wsf[32+crow(r,hi)]);
  bf16*Ow=O+(rowbase+q0+wid*QBLK)*DMO+h*D;
  { bf16*stg=(bf16*)(shm+LDS_OST)+wid*2048;
    #pragma unroll
    for(int r=0;r<16;++r){const int orow=crow(r,hi);
      #pragma unroll
      for(int d0=0;d0<2;++d0)stg[orow*64+d0*32+r32]=__float2bfloat16(o[d0][r]*rli[r]);}
    asm volatile("s_waitcnt lgkmcnt(0)":::"memory");
    #pragma unroll
    for(int i=0;i<4;++i){const int row=i*8+(lane>>3),ch=lane&7; const u32x4 v=*(const u32x4*)(stg+row*64+ch*8); ATTN_STORE16(Ow+(long)row*DMO+ch*8,v);} }
  asm volatile("s_waitcnt lgkmcnt(0)\n\ts_barrier":::"memory");
  #undef DMA_K
  #undef DMA_V
  #undef CMASK
  #undef BIAS
  #undef START
  #undef RESC
  #undef ROT
}
constexpr int ATTN_LDS_BYTES=LDS_BYTES;
#undef SBAR
#undef WAIT_BAR
}
#define XB_TMO      128
#define XB_XCNT(j)  (256  + 64 * (j))
#define XB_XSUB(j)  (1280 + 64 * (j))
#define XB_XGEN(j)  (2304 + 64 * (j))
#define XB_TOP      3328
#define XB_TOPGEN   3392
#define XCD_BAR_WORDS 3456
#define XB_SPIN_CAP (1u << 18)

__device__ __forceinline__ unsigned xb_ld(unsigned* p)              { return __hip_atomic_load(p, __ATOMIC_RELAXED, __HIP_MEMORY_SCOPE_AGENT); }
__device__ __forceinline__ unsigned xb_add(unsigned* p, unsigned v) { return __hip_atomic_fetch_add(p, v, __ATOMIC_RELAXED, __HIP_MEMORY_SCOPE_AGENT); }
__device__ __forceinline__ unsigned xb_xcc_id() { return (unsigned)__builtin_amdgcn_s_getreg((3 << 11) | 20) & 0xFu; }
#define XB_SPIN(cond, bar) do { unsigned _sp = 0; while (cond) { __builtin_amdgcn_s_sleep(1); \
    if ((++_sp & 255u) == 0u) { if (xb_ld(&(bar)[XB_TMO])) break; if (_sp > XB_SPIN_CAP) { atomicAdd(&(bar)[XB_TMO], 1u); break; } } } } while (0)

struct XcdBarrier {
    unsigned* bar; unsigned x;
    volatile LAS unsigned* st;
};

__device__ __forceinline__ XcdBarrier xcd_barrier_post(unsigned* bar, volatile LAS unsigned* st) {
    XcdBarrier b; b.bar = bar; b.x = xb_xcc_id(); b.st = st;
    if (threadIdx.x == 0) (void)xb_add(&bar[XB_XCNT(b.x)], 1u);
    return b;
}
__device__ __forceinline__ void xcd_barrier_complete(unsigned* bar, unsigned x, unsigned& nloc, unsigned& nx) {
    const unsigned G = gridDim.x * gridDim.y * gridDim.z;
    unsigned sum, cnt, mine, sp = 0u;
    for (;;) {
        sum = 0u; cnt = 0u; mine = 0u;
#pragma unroll
        for (unsigned j = 0; j < 16; ++j) { const unsigned c = xb_ld(&bar[XB_XCNT(j)]); sum += c; cnt += (c > 0u) ? 1u : 0u; mine = (j == x) ? c : mine; }
        if (sum == G) break;
        __builtin_amdgcn_s_sleep(1);
        if ((++sp & 255u) == 0u) { if (xb_ld(&bar[XB_TMO])) break; if (sp > XB_SPIN_CAP) { atomicAdd(&bar[XB_TMO], 1u); break; } }
    }
    nloc = mine > 0u ? mine : 1u; nx = cnt > 0u ? cnt : 1u;
}

__device__ __forceinline__ void xcd_barrier(const XcdBarrier& b) {
    asm volatile("s_waitcnt vmcnt(0)" ::: "memory");
    __syncthreads();
    if (threadIdx.x == 0) {
        unsigned* bar = b.bar;
        __builtin_amdgcn_s_waitcnt(0);
        unsigned nloc = b.st[0], nx = b.st[1];
        if (nloc == 0u) { xcd_barrier_complete(bar, b.x, nloc, nx); b.st[0] = nloc; b.st[1] = nx; }
        const unsigned old = xb_add(&bar[XB_XSUB(b.x)], 1u);
        const unsigned gen = old / nloc;
        if (old + 1u == (gen + 1u) * nloc) {
            __builtin_amdgcn_fence(__ATOMIC_RELEASE, "agent");
            asm volatile("s_waitcnt vmcnt(0)" ::: "memory");
            const unsigned og = xb_add(&bar[XB_TOP], 1u);
            const unsigned tg = og / nx;
            if (og + 1u == (tg + 1u) * nx) xb_add(&bar[XB_TOPGEN], 1u);
            else XB_SPIN(xb_ld(&bar[XB_TOPGEN]) == tg, bar);
            __builtin_amdgcn_fence(__ATOMIC_ACQUIRE, "agent");
            xb_add(&bar[XB_XGEN(b.x)], 1u);
            asm volatile("s_waitcnt vmcnt(0)" ::: "memory");
        } else {
            XB_SPIN(xb_ld(&bar[XB_XGEN(b.x)]) == gen, bar);
            __builtin_amdgcn_fence(__ATOMIC_ACQUIRE, "agent");
            asm volatile("s_waitcnt vmcnt(0)" ::: "memory");
        }
    }
    __syncthreads();
}
struct Args { const float* in[21]; float* out; unsigned char* ws; int ph_lo, ph_hi; };
enum { I_X = 0, I_MEM, I_REL, I_MEMNORM, I_NORMF, I_NORMMIX, I_WIN, I_FBIAS, I_GW2, I_GB, I_CNORM, I_WOUT, I_NORMCROSS, I_WCQ, I_WCKV, I_WCO, I_NORMFFN, I_WUP, I_CONVW, I_CONVB, I_WDOWN };
#ifndef PROBE_PH
#define PROBE_PH -1
#endif
#ifndef PROBE_SUB
#define PROBE_SUB 0
#endif
constexpr int LDS_BARW = 149504;
constexpr size_t WS_QG = 938 * MiB, WS_KG = 962 * MiB, WS_END2 = 986 * MiB;
constexpr size_t WS_TOT = WS_DEC + 900 * 1024, WS_OFFS = WS_TOT + 8192, WS_NRM = WS_OFFS + 8192;
constexpr size_t WS_SS = 986 * MiB, SS_BYTES = 2 * MiB;
constexpr int PH_PER_LAYER = 12, N_PHASES = PH_PER_LAYER * DEPTH + 1;

constexpr int WT_IA = 32 * 200, WT_IB = 32 * 64, WT_IC = 32 * 16, WT_ID = 32 * 32, WT_IE = 8 * 64, WT_IF = 32 * 344, WT_IG = 86 * 64;
constexpr int WT_EARLY = WT_IA + WT_IB + WT_IC + WT_ID + WT_IE, WT_NIT = WT_EARLY + WT_IF + WT_IG;
#define WT_FIRST5(r_, ll) do { int q_ = (r_); \
        if (q_ < WT_IA) { wt_item<1>(ap->in[I_WIN] + (size_t)(ll) * D * PROJW, D, PROJW, Win, scr, q_, 200, 1.f, ap->in[I_NORMMIX] + (size_t)(ll) * D, lane); break; } q_ -= WT_IA; \
        if (q_ < WT_IB) { wt_item<0>(ap->in[I_WOUT] + (size_t)(ll) * D * D, D, D, Wout, scr, q_, 64, 1.f, nullptr, lane); break; } q_ -= WT_IB; \
        if (q_ < WT_IC) { wt_item<0>(ap->in[I_WCQ] + (size_t)(ll) * D * CW, D, CW, Wcq, scr, q_, 16, 0.08838834764831845f * LOG2E, ap->in[I_NORMCROSS] + (size_t)(ll) * D, lane); break; } q_ -= WT_IC; \
        if (q_ < WT_ID) { wt_item<0>(ap->in[I_WCKV] + (size_t)(ll) * D * 2 * CW, D, 2 * CW, Wckv, scr, q_, 32, 1.f, nullptr, lane); break; } q_ -= WT_ID; \
        wt_item<0>(ap->in[I_WCO] + (size_t)(ll) * CW * D, CW, D, Wco, scr, q_, 64, 1.f, nullptr, lane); } while (0)

__global__ void __launch_bounds__(NTHR, 2) fwd_mega(Args args) {
    extern __shared__ __attribute__((aligned(16))) unsigned char lds_raw[];
    LAS char* lds = (LAS char*)lds_raw;
    cg::grid_group grid = cg::this_grid();
    const int G0 = gridDim.x, bx0 = blockIdx.x;
    const int vcu0 = (G0 % 8 == 0) ? (bx0 % 8) * (G0 / 8) + bx0 / 8 : bx0;
    typedef const __attribute__((address_space(4))) Args* KArgs;
    KArgs ap = (KArgs)__builtin_amdgcn_kernarg_segment_ptr();
    const int ph_lo = args.ph_lo, ph_hi = args.ph_hi;
    if (threadIdx.x < 2) ((LAS unsigned*)(lds + LDS_BARW))[threadIdx.x] = 0u;
    __syncthreads();
    XcdBarrier bar = xcd_barrier_post((unsigned*)(args.ws + WS_CTL) + 4096, (volatile LAS unsigned*)(lds + LDS_BARW));
    int probe_done = 0, in_rep = 0;
    for (int ph = ph_lo; ph < ph_hi; ++ph) {
        const int tid = otid(), lane = tid & 63; const int wave = __builtin_amdgcn_readfirstlane(tid >> 6);
        int G = G0, bx = bx0, vcu = vcu0; asm volatile("" : "+s"(G), "+s"(bx), "+s"(vcu));
        asm volatile("" : "+s"(ap));
        const int gw = vcu * NWAVES + wave, NGW = G * NWAVES;
        unsigned char* ws = ap->ws;
        bf16* Win = (bf16*)(ws + WS_WIN); bf16* Wout = (bf16*)(ws + WS_WOUT); bf16* Wcq = (bf16*)(ws + WS_WCQ); bf16* Wckv = (bf16*)(ws + WS_WCKV);
        bf16* Wco = (bf16*)(ws + WS_WCO); bf16* Wup = (bf16*)(ws + WS_WUP); bf16* Wdown = (bf16*)(ws + WS_WDOWN);
        bf16* XN = (bf16*)(ws + WS_XN); bf16* OA = (bf16*)ap->out;     bf16* PROJ = (bf16*)(ws + WS_PROJ); bf16* QKVA = (bf16*)(ws + WS_QKVA); bf16* ACT = (bf16*)(ws + WS_ACT);
        bf16* QC = (bf16*)(ws + WS_QC); bf16* OC = (bf16*)(ws + WS_OC); bf16* MIXED = (bf16*)(ws + WS_MIXED); bf16* MEMN = (bf16*)(ws + WS_MEMN); bf16* KVC = (bf16*)(ws + WS_KVC);
        bf16* SC = (bf16*)(ws + WS_SC); float* DEC = (float*)(ws + WS_DEC); float* C2 = (float*)(ws + WS_C2); float* LSE = (float*)(ws + WS_LSE);
        float* GLb = (float*)(ws + WS_GL); float* GFb = (float*)(ws + WS_GF); float* VFb = (float*)(ws + WS_VF);
        unsigned long long* SSB = (unsigned long long*)(ws + WS_SS);
        bf16* QG = (bf16*)(ws + WS_QG); bf16* KG = (bf16*)(ws + WS_KG); float* TOTB = (float*)(ws + WS_TOT); float* OFFS = (float*)(ws + WS_OFFS); float* NRM = (float*)(ws + WS_NRM);
        const int l = ph / PH_PER_LAYER, k = (ph == N_PHASES - 1) ? 99 : ph % PH_PER_LAYER;
        switch (k) {
        case 0: {
            LAS float* scr = (LAS float*)(lds + wave * 16384);
            const float* wup = ap->in[I_WUP] + (size_t)l * D * 2 * DFF; const float* wdown = ap->in[I_WDOWN] + (size_t)l * DFF * D;
            for (int it = ((l > 0 && G == 256) ? WT_EARLY : 0) + gw; it < WT_NIT; it += NGW) {
                int r = it;
                if (r < WT_EARLY) { WT_FIRST5(r, l); continue; } r -= WT_EARLY;
                if (r < WT_IF) { wt_item<2>(wup, D, 2 * DFF, Wup, scr, r, 344, 1.f, ap->in[I_NORMFFN] + (size_t)l * D, lane); continue; } r -= WT_IF;
                wt_item<0>(wdown, DFF, D, Wdown, scr, r, 64, 1.f, nullptr, lane);
            }
            if (l == 0) {
                for (int m = gw; m < T; m += NGW) xconv_row(ap->in[I_X] + (size_t)m * D, XN + (size_t)m * D, SSB + m, lane);
                for (int m = gw; m < BATCH * MEMLEN; m += NGW) norm_row_bf16(ap->in[I_MEM] + (size_t)m * D, ap->in[I_MEMNORM], MEMN + (size_t)m * D, lane);
            }
        } break;
        case 1: {
            { pg8::Gemm g{XN, Win, T, PROJN, D}; pg8::StaticOrder S; S.init(T, PROJN, G, bx); pg8::EpiBf16 E{QKVA, QAP, PROJ, PROJP, QAP / 256, SSB + (size_t)(3 * l) * T};
              pg8::gemm_phase<pg8::EpiBf16, pg8::StaticOrder, true, true>((LAS unsigned char*)lds, g, S, E); }
            { pg8::Gemm g{MEMN, Wckv, BATCH * MEMLEN, 2 * CW, D}; pg8::StaticOrder S; S.init(BATCH * MEMLEN, 2 * CW, G, (bx + G - G / 2) % G); pg8::EpiBf16 E{KVC, 2 * CW, nullptr, 0, 0, nullptr};
              pg8::gemm_phase<pg8::EpiBf16, pg8::StaticOrder, true, true>((LAS unsigned char*)lds, g, S, E); }
        } break;
        case 2: {
            for (int c = vcu; c < T / 128; c += G) fscan_chunk(lds, c, PROJ, ap->in[I_FBIAS] + l * 8, C2, TOTB);
            if (!(in_rep && PROBE_SUB == 1)) for (int j_ = vcu; j_ < 2048; j_ += G) gla_unit<1>(lds, ((j_ >> 9) * 4 + (j_ & 3)) * 128 + ((j_ >> 2) & 127), PROJ,     ap->in[I_GW2] + (size_t)l * 16 * 384, ap->in[I_GB] + l * 384, SC, DEC, nullptr, nullptr, QG, KG);
            if (!(in_rep && PROBE_SUB == 2)) {
                DilRegs RG = {}; DilU cur = {}, nxt = {}; int it = 0;
#define DIL_MAKE(A, uu) do { const int p_ = (uu) / 1536, rem_ = (uu) - 1536 * p_, bc_ = rem_ / 12, h_ = rem_ - 12 * bc_, b_ = bc_ >> 5, cb_ = bc_ & 31;     \
                const int r_ = (p_ == 0) ? 1 : (p_ == 1 ? 4 : 16), nbk_ = 32 / r_, c_ = cb_ / nbk_, n_ = cb_ - nbk_ * c_; \
                const size_t qrow_ = (size_t)b_ * SEQ + c_ + (size_t)r_ * 256 * n_; const long krow_ = (long)b_ * SEQ + c_ + (long)r_ * (256 * n_ - 128); \
                (A).Qb = QKVA + qrow_ * QAP + O_QA + 64 * h_; (A).qstride = r_ * QAP; \
                (A).Kb = QKVA + krow_ * QAP + O_KA + 64 * h_; (A).kstride = r_ * QAP; (A).row_lo = (n_ == 0) ? 128 : 0; \
                (A).Ob = OA + (size_t)p_ * T * 768 + qrow_ * 768 + 64 * h_; (A).ostride = r_ * 768; \
                (A).lse = LSE + (size_t)p_ * T * 12 + qrow_ * 12 + h_; (A).lstride = r_ * 12; } while (0)
#define DIL_TBLP(uu) ((const LAS float*)(lds + DIL_TBLS) + (((uu) / 1536) * 12 + ((uu) % 1536) % 12) * 192)
                for (int e = tid; e < 36 * 192; e += NTHR) { const int tb_ = e / 192, st_ = e - 192 * tb_ - 32, p_ = tb_ / 12, h_ = tb_ - 12 * p_, r_ = (p_ == 0) ? 1 : (p_ == 1 ? 4 : 16); float tv = -INFINITY;
                    if (st_ >= 0 && st_ <= 128) { const int dist = st_ * r_; int bk;
                        if (dist < 16) bk = dist; else { bk = 16 + (int)(logf((float)dist * (1.f / 16.f)) / logf(128.f) * 16.f); bk = bk > 31 ? 31 : bk; }
                        tv = ap->in[I_REL][bk * 12 + h_] * LOG2E; }
                    ((LAS float*)(lds + DIL_TBLS))[e] = tv; }
                if (vcu < 4608) { DIL_MAKE(cur, vcu); DIL_GLOAD(cur, RG); }
                for (int u = vcu; u < 4608; u += G) {
                    const bool has_next = (u + G < 4608);
                    DIL_LWRITE(RG);
                    bf16x8 qf[4];
#pragma unroll
                    for (int d0 = 0; d0 < 4; ++d0) qf[d0] = RG.q[d0];
                    __syncthreads();
                    if (has_next) { DIL_MAKE(nxt, u + G); DIL_GLOAD(nxt, RG); }
                    dil_compute(lds, cur, DIL_TBLP(u), tid, qf);
                    asm volatile("s_waitcnt lgkmcnt(0)\n\ts_barrier" ::: "memory");
                    cur = nxt; ++it;
                }
#undef DIL_MAKE
#undef DIL_TBLP
            }
        } break;
        case 3: {
            if (vcu == G - 1 && tid < 32) { const int b_ = tid >> 3, h_ = tid & 7; float acc = 0.f;
                for (int cc = 0; cc < 64; ++cc) { OFFS[(b_ * 64 + cc) * 8 + h_] = acc; acc += TOTB[(b_ * 64 + cc) * 8 + h_]; } }
            {
                for (int it = gw; it < 2 * 4096; it += NGW) { const int isk = it >= 4096, tt = it & 4095, bh_ = tt >> 7, t64 = tt & 127;
                    const bf16* rp = PROJ + ((size_t)(bh_ >> 3) * SEQ + 64 * t64 + lane) * PROJP + (isk ? O_KB : O_QB) + 64 * (bh_ & 7);
                    float s2 = 0.f;
#pragma unroll
                    for (int c8 = 0; c8 < 8; ++c8) { const u32x4 v = *(const u32x4*)(rp + 8 * c8);
#pragma unroll
                        for (int q = 0; q < 4; ++q) { const float a0 = bflo(v[q]), a1 = bfhi(v[q]); s2 += a0 * a0 + a1 * a1; } }
#pragma unroll
                    for (int o = 1; o < 64; o <<= 1) s2 = fmaxf(s2, __shfl_xor(s2, o));
                    if (lane == 0) NRM[it] = sqrtf(s2); }
            }
            {
                if (tid < 288) for (int pb = vcu * 576; pb < 16 * 9216; pb += G * 576) {
                    unsigned* sp[2]; const float* dp[2]; float st[2][2]; bool ok[2];
#pragma unroll
                    for (int q = 0; q < 2; ++q) { const int pe = pb + tid + 288 * q; ok[q] = pe < 16 * 9216; const int pp = ok[q] ? pe : 0; const int bh = pp / 9216, vk = pp - 9216 * bh, k0 = 2 * (vk % 48);
                        sp[q] = (unsigned*)SC + (size_t)bh * 128 * 9216 + vk; dp[q] = DEC + (size_t)bh * 128 * 96 + k0; st[q][0] = 0.f; st[q][1] = 0.f; }
                    for (int n = 0; n < 128; n += 8) { unsigned tv[2][8]; float d0[2][8], d1[2][8];
#pragma unroll
                        for (int q = 0; q < 2; ++q)
#pragma unroll
                            for (int jj = 0; jj < 8; ++jj) { tv[q][jj] = sp[q][(size_t)(n + jj) * 9216]; d0[q][jj] = dp[q][(n + jj) * 96]; d1[q][jj] = dp[q][(n + jj) * 96 + 1]; }
#pragma unroll
                        for (int q = 0; q < 2; ++q) if (ok[q]) {
#pragma unroll
                            for (int jj = 0; jj < 8; ++jj) { sp[q][(size_t)(n + jj) * 9216] = pk2(st[q][0], st[q][1]);
                                st[q][0] = st[q][0] * d0[q][jj] + bflo(tv[q][jj]); st[q][1] = st[q][1] * d1[q][jj] + bfhi(tv[q][jj]); } } } }
            }
            {
                const int gt = vcu * NTHR + tid, NGT = G * NTHR;
                for (int e0 = gt; e0 < T * 96; e0 += 4 * NGT) {
                    float ls[4][3]; u32x4 ov[4][3]; int tt[4], cc[4]; bool ok[4];
#pragma unroll
                    for (int q = 0; q < 4; ++q) { const int e = e0 + q * NGT; ok[q] = e < T * 96; const int ee = ok[q] ? e : e0; const int t = ee / 96, rem = ee - 96 * t, h = rem >> 3, ch = rem & 7; tt[q] = t; cc[q] = 64 * h + 8 * ch;
#pragma unroll
                        for (int pp = 0; pp < 3; ++pp) { ls[q][pp] = LSE[(size_t)pp * T * 12 + (size_t)t * 12 + h]; ov[q][pp] = *(const u32x4*)(OA + (size_t)pp * T * 768 + (size_t)t * 768 + cc[q]); } }
#pragma unroll
                    for (int q = 0; q < 4; ++q) if (ok[q]) {
                        const float mx = fmaxf(fmaxf(ls[q][0], ls[q][1]), ls[q][2]);
                        float wsum = 0.f, acc[8];
#pragma unroll
                        for (int jj = 0; jj < 8; ++jj) acc[jj] = 0.f;
#pragma unroll
                        for (int pp = 0; pp < 3; ++pp) { const float wp = __builtin_amdgcn_exp2f(ls[q][pp] - mx); wsum += wp;
#pragma unroll
                            for (int x = 0; x < 4; ++x) { acc[2 * x] += wp * bflo(ov[q][pp][x]); acc[2 * x + 1] += wp * bfhi(ov[q][pp][x]); } }
                        const float inv = 1.f / wsum; u32x4 o;
#pragma unroll
                        for (int x = 0; x < 4; ++x) o[x] = pk2(acc[2 * x] * inv, acc[2 * x + 1] * inv);
                        *(u32x4*)(MIXED + (size_t)tt[q] * D + cc[q]) = o; } }
            }
        } break;
        case 4: {
            if (!(in_rep && PROBE_SUB == 1)) for (int j_ = vcu; j_ < 2048; j_ += G) gla_unit<3>(lds, ((j_ >> 9) * 4 + (j_ & 3)) * 128 + ((j_ >> 2) & 127), PROJ, ap->in[I_GW2] + (size_t)l * 16 * 384, ap->in[I_GB] + l * 384, SC, DEC, ap->in[I_CNORM] + l * 192, MIXED, QG, KG);
            if (!(in_rep && PROBE_SUB == 2)) {
                static_assert(attn_body::ATTN_LDS_BYTES <= LDS_BARW, "attention LDS");
                for (int i = 0; i < 4; ++i) {
                    int bh, qb;
                    if (G == 256) { const int s = vcu & 7; bh = vcu >> 3; qb = (i == 0) ? s : (i == 1) ? 15 - s : (i == 2) ? 16 + s : 31 - s; }
                    else { const int u = vcu + i * G; if (u >= 1024) break; bh = u >> 5; qb = u & 31; }
                    int ts = 0;
                    { const int NTf = 4 * (qb + 1); const float* cg = C2 + (size_t)bh * SEQ; const float* og = OFFS + (size_t)(bh >> 3) * 64 * 8 + (bh & 7);
                      const float* qn = NRM + bh * 128 + 4 * qb; const float* kn = NRM + 4096 + bh * 128;
                      const float Qn = fmaxf(fmaxf(qn[0], qn[1]), fmaxf(qn[2], qn[3])) * 1.01f;
                      const int t0_ = lane, t1_ = lane + 64;
                      const float k0_ = (t0_ < NTf) ? kn[t0_] : 0.f, k1_ = (t1_ < NTf) ? kn[t1_] : 0.f;
                      float kmax = fmaxf(k0_, k1_);
#pragma unroll
                      for (int o = 1; o < 64; o <<= 1) kmax = fmaxf(kmax, __shfl_xor(kmax, o));
                      kmax *= 1.01f;
                      const int q0_ = 256 * qb; const float Cq = cg[q0_] + og[(q0_ >> 7) * 8];
                      const float thr = -Qn * kmax - 150.f;
                      bool keep0 = true, keep1 = true;
                      if (t0_ < NTf) { const int e = 64 * t0_ + 63; keep0 = !(Qn * k0_ * 1.01f + (Cq - (cg[e] + og[(e >> 7) * 8])) < thr); }
                      if (t1_ < NTf) { const int e = 64 * t1_ + 63; keep1 = !(Qn * k1_ * 1.01f + (Cq - (cg[e] + og[(e >> 7) * 8])) < thr); }
                      const unsigned long long b0 = __ballot(keep0), b1 = __ballot(keep1);
                      const int first = b0 ? __builtin_ctzll(b0) : 64 + (b1 ? __builtin_ctzll(b1) : 0);
                      ts = first & ~1; if (ts > NTf - 4) ts = NTf - 4; if (ts < 0) ts = 0;
                      ts = __builtin_amdgcn_readfirstlane(ts); }
                    attn_body::attn_unit<40>(bh >> 3, bh & 7, qb, (const attn_body::bf16*)(PROJ + O_QB), (const attn_body::bf16*)(PROJ + O_KB), (const attn_body::bf16*)(PROJ + O_VB),
                                            (attn_body::bf16*)(MIXED + 768), C2 + (size_t)bh * SEQ, OFFS + (size_t)(bh >> 3) * 64 * 8 + (bh & 7), ts, (char*)lds_raw);
                }
            }
        } break;
        case 5: case 8: case 11: {
            pg8::Gemm g; if (k == 5) g = pg8::Gemm{MIXED, Wout, T, D, D}; else if (k == 8) g = pg8::Gemm{OC, Wco, T, D, CW}; else g = pg8::Gemm{ACT, Wdown, T, D, DFF};
            unsigned long long* ssn = SSB + (size_t)(k == 5 ? 3 * l + 1 : (k == 8 ? 3 * l + 2 : 3 * l + 3)) * T;
            pg8::StaticOrder S; S.init(T, D, G, bx); pg8::EpiRes E{XN, D, (k == 11 && l == DEPTH - 1) ? nullptr : ssn};
            pg8::gemm_phase<pg8::EpiRes, pg8::StaticOrder, true, true>((LAS unsigned char*)lds, g, S, E);
        } break;
        case 6: {
            pg8::Gemm g{XN, Wcq, T, CW, D}; pg8::StaticOrder S; S.init(T, CW, G, bx); pg8::EpiBf16 E{QC, CW, nullptr, 0, 0, SSB + (size_t)(3 * l + 1) * T};
            pg8::gemm_phase<pg8::EpiBf16, pg8::StaticOrder, true, true>((LAS unsigned char*)lds, g, S, E);
        } break;
        case 7: {
            for (int u = vcu; u < 512; u += G) { const int b = u >> 7, qb = (u >> 2) & 31, h = u & 3;     const size_t qrow = (size_t)b * SEQ + 256 * qb;
                AttnU a;
                a.Qb = QC + qrow * CW + 128 * h; a.qstride = CW;
                a.Kb = KVC + (size_t)b * MEMLEN * 2 * CW + 128 * h; a.Vb = a.Kb + CW; a.kstride = 2 * CW;
                a.Ob = OC + qrow * CW + 128 * h; a.ostride = CW;
                a.NT = 4; a.t_begin = 0; a.cq = nullptr; a.ck = nullptr; a.q0 = 0; a.lse = nullptr; a.lstride = 0;
                attn_unit<128, 0>(lds, a, nullptr); }
        } break;
        case 9: {
            pg8::Gemm g{XN, Wup, T, 2 * DFF, D}; pg8::StaticOrder S; S.init(T, 2 * DFF, G, bx);
            pg8::EpiConv E{ACT, ap->in[I_CONVW] + (size_t)l * 3 * DFF, ap->in[I_CONVB] + (size_t)l * DFF, GLb, GFb, VFb, SSB + (size_t)(3 * l + 2) * T};
            pg8::gemm_phase<pg8::EpiConv, pg8::StaticOrder, true, true>((LAS unsigned char*)lds, g, S, E);
            if (l + 1 < DEPTH && G == 256 && bx >= 128) {
                LAS float* scr = (LAS float*)(lds + wave * 16384);
                for (int it = (bx - 128) * NWAVES + wave; it < WT_EARLY; it += 128 * NWAVES) WT_FIRST5(it, l + 1);
            }
        } break;
        case 10: {
            const float* cw = ap->in[I_CONVW] + (size_t)l * 3 * DFF; const float* cb = ap->in[I_CONVB] + (size_t)l * DFF;
            const int gt = vcu * NTHR + tid, NGT = G * NTHR;
            for (int e = gt; e < 512 * 1376; e += NGT) { const int sl = e / 1376, c4 = (e - 1376 * sl) * 4;
                f32x4 gm2 = (f32x4){0.f, 0.f, 0.f, 0.f}, gm1 = gm2;
                if (sl % 128 != 0) { gm2 = *(const f32x4*)(GLb + (size_t)((sl - 1) * 2) * DFF + c4); gm1 = *(const f32x4*)(GLb + (size_t)((sl - 1) * 2 + 1) * DFF + c4); }
                const f32x4 g0 = *(const f32x4*)(GFb + (size_t)(sl * 2) * DFF + c4), g1 = *(const f32x4*)(GFb + (size_t)(sl * 2 + 1) * DFF + c4);
                const f32x4 v0 = *(const f32x4*)(VFb + (size_t)(sl * 2) * DFF + c4), v1 = *(const f32x4*)(VFb + (size_t)(sl * 2 + 1) * DFF + c4);
                const f32x4 w0 = *(const f32x4*)(cw + c4), w1 = *(const f32x4*)(cw + DFF + c4), w2 = *(const f32x4*)(cw + 2 * DFF + c4), b4 = *(const f32x4*)(cb + c4);
                const f32x4 a0 = b4 + w0 * gm2 + w1 * gm1 + w2 * g0, a1 = b4 + w0 * gm1 + w1 * g0 + w2 * g1;
                float y0[4], y1[4];
#pragma unroll
                for (int q = 0; q < 4; ++q) { y0[q] = a0[q] / (1.f + __expf(-a0[q])) * v0[q]; y1[q] = a1[q] / (1.f + __expf(-a1[q])) * v1[q]; }
                u32x2 o0, o1; o0.x = pk2(y0[0], y0[1]); o0.y = pk2(y0[2], y0[3]); o1.x = pk2(y1[0], y1[1]); o1.y = pk2(y1[2], y1[3]);
                *(u32x2*)(ACT + (size_t)(64 * sl) * DFF + c4) = o0; *(u32x2*)(ACT + (size_t)(64 * sl + 1) * DFF + c4) = o1; }
        } break;
        default: {
            for (int m = gw; m < T; m += NGW) norm_row_out(XN + (size_t)m * D, ap->in[I_NORMF], ap->out + (size_t)m * D, lane);
        } break;
        }
        if (ph == PROBE_PH && !probe_done) { probe_done = 1; in_rep = 1; xcd_barrier(bar); --ph; continue; }
        in_rep = 0;
        if (ph + 1 < ph_hi) { if (ph == ph_lo) grid.sync(); else xcd_barrier(bar); }
    }
}

#ifndef N_LAUNCH_MODE
#define N_LAUNCH_MODE 1
#endif
extern "C" void kernel_launch(void* const* d_in, const int* in_sizes, int n_in, void* d_out, int out_size, void* d_ws, size_t ws_size, hipStream_t stream) {
    static int grid = 0;
    if (grid == 0) {
        if (n_in != 21 || out_size != T * D || ws_size < WS_SS + SS_BYTES) { fprintf(stderr, "kernel_launch: unexpected problem (n_in %d out %d ws %zu)\n", n_in, out_size, ws_size); grid = -1; return; }
        int dev = 0, cus = 0, per_cu = 0;
        hipGetDevice(&dev); hipDeviceGetAttribute(&cus, hipDeviceAttributeMultiprocessorCount, dev);
        if (hipFuncSetAttribute((const void*)fwd_mega, hipFuncAttributeMaxDynamicSharedMemorySize, LDS_BYTES) != hipSuccess) { fprintf(stderr, "kernel_launch: hipFuncSetAttribute failed\n"); grid = -1; return; }
        hipOccupancyMaxActiveBlocksPerMultiprocessor(&per_cu, (const void*)fwd_mega, NTHR, LDS_BYTES);
        (void)hipGetLastError();
        if (per_cu < 1) { fprintf(stderr, "kernel_launch: occupancy query says %d blocks per CU\n", per_cu); per_cu = 1; }
        grid = cus;
    }
    if (grid < 0) return;
    if (hipMemsetAsync((char*)d_ws + WS_CTL, 0, 1u << 20, stream) != hipSuccess) { fprintf(stderr, "kernel_launch: memset failed\n"); return; }
    if (hipMemsetAsync((char*)d_ws + WS_SS, 0, SS_BYTES, stream) != hipSuccess) { fprintf(stderr, "kernel_launch: memset failed\n"); return; }
    Args a{};
    for (int i = 0; i < 21; ++i) a.in[i] = (const float*)d_in[i];
    a.out = (float*)d_out; a.ws = (unsigned char*)d_ws;
#if N_LAUNCH_MODE == 1
    a.ph_lo = 0; a.ph_hi = N_PHASES;
    void* kargs[] = {&a};
    hipError_t e = hipLaunchCooperativeKernel((const void*)fwd_mega, dim3(grid), dim3(NTHR), kargs, LDS_BYTES, stream);
    if (e != hipSuccess) fprintf(stderr, "kernel_launch: cooperative launch failed: %s (grid %d)\n", hipGetErrorString(e), grid);
#else
    for (int ph = 0; ph < N_PHASES; ++ph) { a.ph_lo = ph; a.ph_hi = ph + 1; hipLaunchKernelGGL(fwd_mega, dim3(grid), dim3(NTHR), LDS_BYTES, stream, a); }
#endif
}
```
